# Optimizing an MI355X kernel written in HIP

```python
import math
import jax, jax.numpy as jnp
from jax import lax
import numpy as np

D_MODEL = 2048
BATCH = 4
SEQ = 4096
DEPTH = 2

HEAD_DIM = 128
A_WIDTH = D_MODEL // 2
A_GROUPS = A_WIDTH // 128
CHUNK = 128
B_HEADS = (D_MODEL // 2) // HEAD_DIM
B_WIDTH = B_HEADS * HEAD_DIM
DILATED_PAIRS = ((128, 1), (512, 4), (2048, 16))
ATT_BLOCK = 128
C_HEADS = D_MODEL // HEAD_DIM
C_WIDTH = C_HEADS * HEAD_DIM
D_FF = 4 * D_MODEL
N_EVEN = (DEPTH + 1) // 2
N_ODD = DEPTH // 2
RMS_EPS = 1e-6
LN_EPS = 1e-5

kernel_name = "hybrid_gmlp_dilated_stickbreak_trunk"


def rmsnorm(x, g):
    xf = x.astype(jnp.float32)
    y = xf * lax.rsqrt(jnp.mean(xf * xf, axis=-1, keepdims=True) + RMS_EPS)
    return (y * g.astype(jnp.float32)).astype(x.dtype)


def layernorm(x, g, b):
    xf = x.astype(jnp.float32)
    mu = jnp.mean(xf, axis=-1, keepdims=True)
    var = jnp.mean(jnp.square(xf - mu), axis=-1, keepdims=True)
    y = (xf - mu) * lax.rsqrt(var + LN_EPS)
    return (y * g.astype(jnp.float32) + b.astype(jnp.float32)).astype(x.dtype)


def alibi_slopes(n):
    return jnp.exp2(-8.0 * (jnp.arange(n, dtype=jnp.float32) + 1.0) / n)


def spatial_gating_unit(u, v, ln_g, ln_b, w_s, b_s):
    bsz, t, _ = v.shape
    v = layernorm(v, ln_g, ln_b)
    vg = v.reshape(bsz, t // CHUNK, CHUNK, A_GROUPS, A_WIDTH // A_GROUPS)
    w = jnp.tril(w_s).astype(v.dtype)
    mixed = jnp.einsum('gij,bcjgd->bcigd', w, vg) + b_s.T.astype(v.dtype)[None, None, :, :, None]
    return u * mixed.reshape(bsz, t, A_WIDTH)


def dilated_branch(q, k, v, window, dilation, slopes):
    bsz, t, h, dh = q.shape
    blk = ATT_BLOCK
    win_sub = window // dilation
    period = dilation * blk
    tp = -(-t // period) * period
    pad = tp - t
    sub_len = tp // dilation
    nb = sub_len // blk

    def to_sub(a):
        a = jnp.pad(a, ((0, 0), (0, pad), (0, 0), (0, 0)))
        a = a.reshape(bsz, sub_len, dilation, h, dh).transpose(0, 2, 3, 1, 4)
        return a.reshape(bsz, dilation, h, nb, blk, dh)

    qs, ks, vs = to_sub(q), to_sub(k), to_sub(v)

    def with_prev(a):
        prev = jnp.concatenate([jnp.zeros_like(a[:, :, :, :1]), a[:, :, :, :-1]], axis=3)
        return jnp.concatenate([prev, a], axis=4)

    kw, vw = with_prev(ks), with_prev(vs)
    s = jnp.einsum('brhnqe,brhnke->brhnqk', qs, kw).astype(jnp.float32)

    qi = jnp.arange(blk)[:, None]
    kj = jnp.arange(2 * blk)[None, :]
    dist = qi + blk - kj
    band = (dist >= 0) & (dist <= win_sub)
    first = (jnp.arange(nb) == 0)[:, None, None] & (kj < blk)[None]
    valid = band[None] & ~first
    bias = -slopes[:, None, None] * (dist * dilation).astype(jnp.float32)[None]
    s = s + bias[None, None, :, None]
    s = jnp.where(valid[None, None, None], s, -jnp.inf)
    m = jnp.max(s, axis=-1, keepdims=True)
    p = jnp.exp(s - m)
    den = jnp.sum(p, axis=-1, keepdims=True)
    o = jnp.einsum('brhnqk,brhnke->brhnqe', p, vw.astype(jnp.float32)) / den
    lse = (m + jnp.log(den))[..., 0]

    o = o.reshape(bsz, dilation, h, sub_len, dh).transpose(0, 3, 1, 2, 4).reshape(bsz, tp, h, dh)[:, :t]
    lse = lse.reshape(bsz, dilation, h, sub_len).transpose(0, 3, 1, 2).reshape(bsz, tp, h)[:, :t]
    return o, lse


def dilated_mixture(q, k, v):
    slopes = alibi_slopes(q.shape[2])
    outs, lses = [], []
    for window, dilation in DILATED_PAIRS:
        o, lse = dilated_branch(q, k, v, window, dilation, slopes)
        outs.append(o)
        lses.append(lse)
    wts = jax.nn.softmax(jnp.stack(lses, axis=0), axis=0)
    o = jnp.sum(wts[..., None] * jnp.stack(outs, axis=0), axis=0)
    return o.astype(q.dtype)


def gmlp_dilated_layer(h, w_in, ln_g, ln_b, w_s, b_s, w_out):
    bsz, t, _ = h.shape
    z = h @ w_in
    u, va, q, k, vb = jnp.split(z, [A_WIDTH, 2 * A_WIDTH, 2 * A_WIDTH + B_WIDTH, 2 * A_WIDTH + 2 * B_WIDTH], axis=-1)
    a_out = spatial_gating_unit(jax.nn.gelu(u, approximate=False), jax.nn.gelu(va, approximate=False), ln_g, ln_b, w_s, b_s)
    q = q.reshape(bsz, t, B_HEADS, HEAD_DIM) * (HEAD_DIM ** -0.5)
    k = k.reshape(bsz, t, B_HEADS, HEAD_DIM)
    vb = vb.reshape(bsz, t, B_HEADS, HEAD_DIM)
    b_out = dilated_mixture(q, k, vb).reshape(bsz, t, B_WIDTH)
    return jnp.concatenate([a_out, b_out], axis=-1) @ w_out


def stick_breaking_attention(q, k, v):
    bsz, h, t, dh = q.shape
    nb = t // ATT_BLOCK
    qb = q.reshape(bsz, h, nb, ATT_BLOCK, dh).transpose(2, 0, 1, 3, 4)
    kpos = jnp.arange(t)

    def block(args):
        qblk, start = args
        z = jnp.einsum('bhqe,bhke->bhqk', qblk, k).astype(jnp.float32)
        qpos = start + jnp.arange(ATT_BLOCK)
        causal = kpos[None, :] < qpos[:, None]
        log_1m_beta = jnp.where(causal, jax.nn.log_sigmoid(-z), 0.0)
        rev = lax.cumsum(log_1m_beta, axis=3, reverse=True)
        excl = jnp.concatenate([rev[..., 1:], jnp.zeros_like(rev[..., :1])], axis=-1)
        a = jnp.where(causal, jnp.exp(jax.nn.log_sigmoid(z) + excl), 0.0)
        return jnp.einsum('bhqk,bhke->bhqe', a.astype(v.dtype), v)

    o = lax.map(block, (qb, jnp.arange(nb) * ATT_BLOCK))
    return o.transpose(1, 0, 3, 2, 4).reshape(bsz, t, h * dh)


def stick_breaking_layer(h, w_in, w_out):
    bsz, t, _ = h.shape
    q, k, v = jnp.split(h @ w_in, 3, axis=-1)
    def heads(a):
        return a.reshape(bsz, t, C_HEADS, HEAD_DIM).transpose(0, 2, 1, 3)
    o = stick_breaking_attention(heads(q) * (HEAD_DIM ** -0.5), heads(k), heads(v))
    return o @ w_out


def squared_relu_mlp(h, w1, w2):
    return jnp.square(jax.nn.relu(h @ w1)) @ w2


def setup_inputs(seed: int = 0) -> dict:
    key = jax.random.key(seed)
    ks = jax.random.split(key, 16)
    f32 = jnp.float32
    def nrm(k, shape, scale):
        return jax.random.normal(k, shape, f32) * scale
    def gain(k, shape):
        return 1.0 + 0.02 * jax.random.normal(k, shape, f32)
    return {
        "x": jax.random.normal(ks[0], (BATCH, SEQ, D_MODEL), f32),
        "norm_pre_mix": gain(ks[1], (DEPTH, D_MODEL)),
        "norm_post_mix": gain(ks[2], (DEPTH, D_MODEL)),
        "norm_pre_ffn": gain(ks[3], (DEPTH, D_MODEL)),
        "norm_post_ffn": gain(ks[4], (DEPTH, D_MODEL)),
        "ab_w_in": nrm(ks[5], (N_EVEN, D_MODEL, 2 * A_WIDTH + 3 * B_WIDTH), D_MODEL ** -0.5),
        "sgu_ln_g": gain(ks[6], (N_EVEN, A_WIDTH)),
        "sgu_ln_b": nrm(ks[7], (N_EVEN, A_WIDTH), 0.02),
        "sgu_w": nrm(ks[8], (N_EVEN, A_GROUPS, CHUNK, CHUNK), CHUNK ** -0.5),
        "sgu_b": 1.0 + nrm(ks[9], (N_EVEN, A_GROUPS, CHUNK), 0.1),
        "ab_w_out": nrm(ks[10], (N_EVEN, A_WIDTH + B_WIDTH, D_MODEL), (A_WIDTH + B_WIDTH) ** -0.5),
        "sb_w_in": nrm(ks[11], (N_ODD, D_MODEL, 3 * C_WIDTH), D_MODEL ** -0.5),
        "sb_w_out": nrm(ks[12], (N_ODD, C_WIDTH, D_MODEL), C_WIDTH ** -0.5),
        "ffn_w1": nrm(ks[13], (DEPTH, D_MODEL, D_FF), D_MODEL ** -0.5),
        "ffn_w2": nrm(ks[14], (DEPTH, D_FF, D_MODEL), D_FF ** -0.5),
    }


def reference(x, norm_pre_mix, norm_post_mix, norm_pre_ffn, norm_post_ffn,
              ab_w_in, sgu_ln_g, sgu_ln_b, sgu_w, sgu_b, ab_w_out,
              sb_w_in, sb_w_out, ffn_w1, ffn_w2):
    for layer in range(DEPTH):
        h = rmsnorm(x, norm_pre_mix[layer])
        i = layer // 2
        if layer % 2 == 0:
            y = gmlp_dilated_layer(h, ab_w_in[i], sgu_ln_g[i], sgu_ln_b[i], sgu_w[i], sgu_b[i], ab_w_out[i])
        else:
            y = stick_breaking_layer(h, sb_w_in[i], sb_w_out[i])
        x = x + rmsnorm(y, norm_post_mix[layer])
        h = rmsnorm(x, norm_pre_ffn[layer])
        y = squared_relu_mlp(h, ffn_w1[layer], ffn_w2[layer])
        x = x + rmsnorm(y, norm_post_ffn[layer])
    return x
```

```cpp
#include <hip/hip_runtime.h>
#include <hip/hip_cooperative_groups.h>
#include <cstdio>
#include <cstdint>
#define GAS __attribute__((address_space(1)))
__device__ __forceinline__ int opaque_tid() { int t = (int)threadIdx.x; asm volatile("" : "+v"(t)); return t; }
namespace pg8 {
#define PG8_LAS __attribute__((address_space(3)))
typedef unsigned short bf16_t;
typedef short bf16x8 __attribute__((ext_vector_type(8)));
typedef float f32x4 __attribute__((ext_vector_type(4)));
typedef unsigned u32x4 __attribute__((ext_vector_type(4)));
constexpr int BM = 256, BK = 64, HALF = 128, HTB = HALF * BK * 2  , STAGE_BYTES = 8 * HTB, NXCD = 8, WGM = 4;

__host__ __device__ __forceinline__ int lds_byte(int r, int c) { const int st = (r >> 4) * 2 + (c >> 5), rr = r & 15, cc = c & 31, ob = rr * 64 + cc * 2; return st * 1024 + (ob ^ (((ob >> 9) & 1) << 5)); }
__host__ __device__ __forceinline__ void stage_rc(int b, int& R, int& C) { const int st = b / 1024, sb = b % 1024, swz = sb ^ (((sb >> 9) & 1) << 5); R = (st >> 1) * 16 + swz / 64; C = (st & 1) * 32 + (swz % 64) / 2; }
__host__ __device__ __forceinline__ int perm32(int rho) { const int n = rho >> 4, i = rho & 15; return 8 * (i >> 2) + 4 * n + (i & 3); }

struct Unit { int pm, pn; };
struct Gemm { const GAS bf16_t* A; const GAS bf16_t* Bt; int M, N, K; };

struct StaticOrder {
    int nM, nN, nwg, G, c, wgm, rev;
    __host__ __device__ void init(int M, int N, int G_, int c_, int wgm_ = WGM, int rev_ = 0) { nM = M / BM; nN = N / BM; nwg = nM * nN; G = G_; c = c_; wgm = wgm_; rev = rev_; }
    __host__ __device__ bool next(int i, Unit& u) const {
        const long L = (long)i * G + c; if (L >= nwg) return false;
        int wgid = (int)L; { const int q = nwg / NXCD, r = nwg % NXCD, xcd = wgid % NXCD; int off = wgid / NXCD; if (rev) off = (xcd < r ? q : q - 1) - off;
            wgid = (xcd < r ? xcd * (q + 1) : r * (q + 1) + (xcd - r) * q) + off; }
        const int nig = wgm * nN, gid = wgid / nig, fm = gid * wgm, gsz = (nM - fm) < wgm ? (nM - fm) : wgm;
        u.pm = fm + ((wgid % nig) % gsz); u.pn = (wgid % nig) / gsz; return true;
    }
    __device__ __forceinline__ void a_ready(const Unit&) const {}
    __device__ __forceinline__ void done(const Unit&) const {}
};

__device__ __forceinline__ unsigned cvt_pk_bf16(float lo, float hi) { unsigned r; asm volatile("v_cvt_pk_bf16_f32 %0, %1, %2" : "=v"(r) : "v"(lo), "v"(hi)); return r; }
typedef float f32x2 __attribute__((ext_vector_type(2)));
__device__ __forceinline__ f32x2 gelu_pk(f32x2 v) {
    const f32x2 av = __builtin_elementwise_abs(v), d = av * 0.2316418882f + 1.0f;
    f32x2 t; t.x = __builtin_amdgcn_rcpf(d.x); t.y = __builtin_amdgcn_rcpf(d.y);
    f32x2 q = t * 0.5307027145f + (-0.7265760135f); q = q * t + 0.7107068705f; q = q * t + (-0.142248368f); q = q * t + 0.127414796f; q = q * t;
    const f32x2 s = (v * v) * (-0.72134752044f);
    f32x2 e; e.x = __builtin_amdgcn_exp2f(s.x); e.y = __builtin_amdgcn_exp2f(s.y);
    const f32x2 m = v * (q * e), r = v - m;
    f32x2 o; o.x = v.x < 0.f ? m.x : r.x; o.y = v.y < 0.f ? m.y : r.y; return o;
}

struct EpiGen {
    static constexpr bool PERM = true, AFTER_DRAIN = false;
    GAS bf16_t* O; int ldc; int gelu_tiles; int sc_lo, sc_hi; float sc; int relu2; const GAS float* rs;
    __device__ __forceinline__ void pre(const Unit& u, PG8_LAS unsigned char* lds, int wid, int wr, int lane, int ui) const {
        if (rs) {
#pragma unroll
            for (int ai = 0; ai < 2; ++ai)
                __builtin_amdgcn_global_load_lds((const GAS unsigned*)(rs + (size_t)u.pm * BM + ai * HALF + wr * 64 + lane), (PG8_LAS unsigned*)(lds + 131072 + (ui & 1) * 4096 + wid * 512 + ai * 256), 4, 0, 0);
        }
    }
    __device__ __forceinline__ void operator()(const f32x4 (&acc)[2][2][4][2], const Unit& u, int wr, int wc, int fr, int fq, PG8_LAS unsigned char* lds, int wid, int ui) const {
        const PG8_LAS float* rsl = (const PG8_LAS float*)(lds + 131072 + (ui & 1) * 4096 + wid * 512);
        const int row0 = u.pm * BM + wr * 64 + fr, col0 = u.pn * BM + wc * 32 + 8 * fq;
        const bool do_gelu = u.pn < gelu_tiles;
        const float s = (u.pn >= sc_lo && u.pn < sc_hi) ? sc : 1.f;
#pragma unroll
        for (int ai = 0; ai < 2; ++ai)
#pragma unroll
            for (int m = 0; m < 4; ++m) { GAS bf16_t* rowp = O + (size_t)(row0 + ai * HALF + m * 16) * ldc + col0; const float rsc = rs ? rsl[ai * 64 + m * 16 + fr] : 1.f;
#pragma unroll
                for (int bj = 0; bj < 2; ++bj) { f32x4 v0 = acc[ai][bj][m][0] * rsc, v1 = acc[ai][bj][m][1] * rsc;
                    if (do_gelu) { f32x2 a = gelu_pk((f32x2){v0[0], v0[1]}), b = gelu_pk((f32x2){v0[2], v0[3]}), c = gelu_pk((f32x2){v1[0], v1[1]}), d = gelu_pk((f32x2){v1[2], v1[3]});
                        v0 = (f32x4){a.x, a.y, b.x, b.y}; v1 = (f32x4){c.x, c.y, d.x, d.y}; }
                    if (relu2) {
#pragma unroll
                        for (int j = 0; j < 4; ++j) { const float t0 = fmaxf(v0[j], 0.f), t1 = fmaxf(v1[j], 0.f); v0[j] = t0 * t0; v1[j] = t1 * t1; } }
                    v0 = v0 * s; v1 = v1 * s;
                    u32x4 w; w.x = cvt_pk_bf16(v0[0], v0[1]); w.y = cvt_pk_bf16(v0[2], v0[3]); w.z = cvt_pk_bf16(v1[0], v1[1]); w.w = cvt_pk_bf16(v1[2], v1[3]);
                    #ifdef EPI_NT
                    __builtin_nontemporal_store(w, (GAS u32x4*)(rowp + bj * HALF)); } }
#else
                    *(GAS u32x4*)(rowp + bj * HALF) = w; } }
#endif
    }
};

template <class Epi, class Sched, bool ALIGN_EPI = false, bool SP2 = false>
__device__ __forceinline__ void gemm_phase(PG8_LAS unsigned char* lds, const Gemm g, const Sched& S, const Epi& E) {
    const int tid = opaque_tid(), wid = __builtin_amdgcn_readfirstlane(tid >> 6), lane = tid & 63, wr = wid >> 2, wc = wid & 3, fr = lane & 15, fq = lane >> 4;
    const int K = g.K, nt = K / BK;
    unsigned voffA[2], voffB[2];
#pragma unroll
    for (int i = 0; i < 2; ++i) { int R, C; stage_rc(tid * 16 + i * 8192, R, C); const int Rb = Epi::PERM ? ((R & ~31) + perm32(R & 31)) : R;
        voffA[i] = (unsigned)(R * K + C) * 2u; voffB[i] = (unsigned)(Rb * K + C) * 2u; }
    const size_t kstep = (size_t)(BK * 2);
    const size_t hstep = (size_t)HALF * K * 2;
    const size_t tstep = 2 * hstep;
    const unsigned ldsw = (unsigned)wid * 1024u;
    const int aoff = lds_byte(wr * 64 + fr, fq * 8), boff = lds_byte(wc * 32 + fr, fq * 8);
#ifndef PG8_PFD
#define PG8_PFD 0
#endif
    const int pfi = tid;
    const bool pfB = (pfi >> 8) != 0;
    const unsigned pfoff = (unsigned)(((pfi >> 7) & 1) * (HALF * K * 2) + (pfi & 127) * (K * 2));
#define PG8_PF(kt) do { if (PG8_PFD) { int kt_ = (kt); const GAS char* pa_ = cA; const GAS char* pb_ = cB; if (kt_ >= nt) { kt_ -= nt; pa_ = nA; pb_ = nB; } \
        const GAS char* p_ = (pfB ? pb_ : pa_) + pfoff + (size_t)kt_ * kstep; \
        __builtin_amdgcn_global_load_lds((const GAS unsigned*)p_, (PG8_LAS unsigned*)(lds + 131072 + wid * 256), 4, 0, 0); } } while (0)
#define PG8_WAIT_VL() do { if (PG8_PFD) PG8_WAIT_V(9); else PG8_WAIT_V(8); } while (0)
#define PG8_SA(b, h) (((b) * 2 + (h)) * HTB)
#define PG8_SB(b, h) ((4 + (b) * 2 + (h)) * HTB)
#ifndef PG8_AUX_A
#define PG8_AUX_A 0
#endif
#ifndef PG8_AUX_B
#define PG8_AUX_B 0
#endif
#define PG8_STAGE(bufoff, gbase, voff) do { _Pragma("unroll") for (int _i = 0; _i < 2; ++_i) { \
        if ((bufoff) < 4 * HTB) __builtin_amdgcn_global_load_lds((const GAS unsigned*)((const GAS char*)(gbase) + (voff)[_i]), (PG8_LAS unsigned*)(lds + (bufoff) + ldsw + _i * 8192), 16, 0, PG8_AUX_A); \
        else __builtin_amdgcn_global_load_lds((const GAS unsigned*)((const GAS char*)(gbase) + (voff)[_i]), (PG8_LAS unsigned*)(lds + (bufoff) + ldsw + _i * 8192), 16, 0, PG8_AUX_B); } } while (0)
#define PG8_LDA(dst, b, h) do { _Pragma("unroll") for (int m = 0; m < 4; ++m) _Pragma("unroll") for (int k = 0; k < 2; ++k) dst[m][k] = *(const PG8_LAS bf16x8*)(lds + PG8_SA(b, h) + aoff + m * 2048 + k * 1024); } while (0)
#define PG8_LDB(dst, b, h) do { _Pragma("unroll") for (int n = 0; n < 2; ++n) _Pragma("unroll") for (int k = 0; k < 2; ++k) dst[n][k] = *(const PG8_LAS bf16x8*)(lds + PG8_SB(b, h) + boff + n * 2048 + k * 1024); } while (0)
#define PG8_MMA(ai, bj, At, Bt) do { __builtin_amdgcn_s_setprio(1); _Pragma("unroll") for (int m = 0; m < 4; ++m) _Pragma("unroll") for (int n = 0; n < 2; ++n) _Pragma("unroll") for (int k = 0; k < 2; ++k) \
        acc[ai][bj][m][n] = __builtin_amdgcn_mfma_f32_16x16x32_bf16(Bt[n][k], At[m][k], acc[ai][bj][m][n], 0, 0, 0); __builtin_amdgcn_s_setprio(0); } while (0)
#define PG8_WAIT_V(n) asm volatile("s_waitcnt vmcnt(" #n ")" ::: "memory")
#define PG8_WAIT_L(n) asm volatile("s_waitcnt lgkmcnt(" #n ")" ::: "memory")
#define PG8_BAR __builtin_amdgcn_s_barrier()
#define PG8_SCHED __builtin_amdgcn_sched_barrier(0)
    Unit cur, nxt; int ui = 0;
    if (!S.next(0, cur)) return;
    f32x4 acc[2][2][4][2];
#pragma unroll
    for (int a = 0; a < 2; ++a)
#pragma unroll
        for (int b = 0; b < 2; ++b)
#pragma unroll
            for (int m = 0; m < 4; ++m)
#pragma unroll
                for (int n = 0; n < 2; ++n) acc[a][b][m][n] = (f32x4){0.f, 0.f, 0.f, 0.f};
    bf16x8 At[4][2], B0[2][2], B1[2][2];
    const GAS char* cA = (const GAS char*)g.A + (size_t)cur.pm * tstep; const GAS char* cB = (const GAS char*)g.Bt + (size_t)cur.pn * tstep;
    S.a_ready(cur);
    if constexpr (SP2) {
        PG8_STAGE(PG8_SB(0, 0), cB, voffB); PG8_STAGE(PG8_SB(0, 1), cB + hstep, voffB); PG8_STAGE(PG8_SA(0, 0), cA, voffA); PG8_STAGE(PG8_SA(0, 1), cA + hstep, voffA);
        if (wr == 1) PG8_BAR;
        PG8_WAIT_V(2); PG8_BAR;
        PG8_STAGE(PG8_SB(1, 0), cB + kstep, voffB); PG8_STAGE(PG8_SA(1, 0), cA + kstep, voffA); PG8_STAGE(PG8_SB(1, 1), cB + hstep + kstep, voffB);
        PG8_WAIT_V(6); PG8_BAR;
    } else {
        PG8_STAGE(PG8_SB(0, 0), cB, voffB); PG8_STAGE(PG8_SA(0, 0), cA, voffA); PG8_STAGE(PG8_SB(0, 1), cB + hstep, voffB); PG8_STAGE(PG8_SA(0, 1), cA + hstep, voffA);
        if (wr == 1) PG8_BAR;
        PG8_WAIT_V(4); PG8_BAR;
        PG8_STAGE(PG8_SB(1, 0), cB + kstep, voffB); PG8_STAGE(PG8_SA(1, 0), cA + kstep, voffA); PG8_STAGE(PG8_SB(1, 1), cB + hstep + kstep, voffB);
        PG8_WAIT_V(6); PG8_BAR;
    }
    for (;;) {
        const bool has_next = S.next(ui + 1, nxt);
        E.pre(cur, lds, wid, wr, lane, ui);
        const GAS char* nA = has_next ? (const GAS char*)g.A + (size_t)nxt.pm * tstep : cA; const GAS char* nB = has_next ? (const GAS char*)g.Bt + (size_t)nxt.pn * tstep : cB;
        for (int t = 0; t < nt; t += 2) {
            const bool last = (t == nt - 2);
            const GAS char* a1 = cA + (size_t)(t + 1) * kstep;
            const GAS char* a2 = last ? nA : cA + (size_t)(t + 2) * kstep; const GAS char* b2 = last ? nB : cB + (size_t)(t + 2) * kstep;
            const GAS char* a3 = a2 + kstep; const GAS char* b3 = b2 + kstep;
            if (last && has_next) S.a_ready(nxt);
            if constexpr (SP2) {
            PG8_LDB(B0, 0, 0); PG8_LDB(B1, 0, 1); PG8_SCHED; PG8_LDA(At, 0, 0); PG8_STAGE(PG8_SA(1, 1), a1 + hstep, voffA);
            PG8_WAIT_VL(); PG8_WAIT_L(0); PG8_BAR; PG8_MMA(0, 0, At, B0); PG8_MMA(0, 1, At, B1); PG8_BAR; PG8_SCHED;
            PG8_LDA(At, 0, 1); PG8_STAGE(PG8_SB(0, 0), b2, voffB); PG8_STAGE(PG8_SB(0, 1), b2 + hstep, voffB); PG8_STAGE(PG8_SA(0, 0), a2, voffA); PG8_PF(t + PG8_PFD);
            PG8_WAIT_VL(); PG8_WAIT_L(0); PG8_BAR; PG8_MMA(1, 0, At, B0); PG8_MMA(1, 1, At, B1); PG8_BAR; PG8_SCHED;
            PG8_LDB(B0, 1, 0); PG8_LDB(B1, 1, 1); PG8_SCHED; PG8_LDA(At, 1, 0); PG8_STAGE(PG8_SA(0, 1), a2 + hstep, voffA);
            PG8_WAIT_VL(); PG8_WAIT_L(0); PG8_BAR; PG8_MMA(0, 0, At, B0); PG8_MMA(0, 1, At, B1); PG8_BAR; PG8_SCHED;
            PG8_LDA(At, 1, 1); PG8_STAGE(PG8_SB(1, 0), b3, voffB); PG8_STAGE(PG8_SB(1, 1), b3 + hstep, voffB); PG8_STAGE(PG8_SA(1, 0), a3, voffA); PG8_PF(t + 1 + PG8_PFD);
            PG8_WAIT_VL(); PG8_WAIT_L(0); PG8_BAR; PG8_MMA(1, 0, At, B0); PG8_MMA(1, 1, At, B1); PG8_BAR; PG8_SCHED;
            } else {
            PG8_LDB(B0, 0, 0); PG8_SCHED; PG8_LDA(At, 0, 0); PG8_STAGE(PG8_SA(1, 1), a1 + hstep, voffA);
            PG8_WAIT_L(8); PG8_BAR; PG8_WAIT_L(0); PG8_MMA(0, 0, At, B0); PG8_BAR; PG8_SCHED;
            PG8_LDB(B1, 0, 1); PG8_STAGE(PG8_SB(0, 0), b2, voffB);
            PG8_BAR; PG8_WAIT_L(0); PG8_MMA(0, 1, At, B1); PG8_BAR;
            PG8_LDA(At, 0, 1); PG8_STAGE(PG8_SA(0, 0), a2, voffA);
            PG8_BAR; PG8_WAIT_L(0); PG8_MMA(1, 0, At, B0); PG8_BAR; PG8_SCHED;
            PG8_STAGE(PG8_SB(0, 1), b2 + hstep, voffB);
            PG8_WAIT_V(6); PG8_BAR; PG8_MMA(1, 1, At, B1); PG8_BAR;
            PG8_LDB(B0, 1, 0); PG8_SCHED; PG8_LDA(At, 1, 0); PG8_STAGE(PG8_SA(0, 1), a2 + hstep, voffA);
            PG8_WAIT_L(8); PG8_BAR; PG8_WAIT_L(0); PG8_MMA(0, 0, At, B0); PG8_BAR; PG8_SCHED;
            PG8_LDB(B1, 1, 1); PG8_STAGE(PG8_SB(1, 0), b3, voffB);
            PG8_BAR; PG8_WAIT_L(0); PG8_MMA(0, 1, At, B1); PG8_BAR;
            PG8_LDA(At, 1, 1); PG8_STAGE(PG8_SA(1, 0), a3, voffA);
            PG8_BAR; PG8_WAIT_L(0); PG8_MMA(1, 0, At, B0); PG8_BAR; PG8_SCHED;
            PG8_STAGE(PG8_SB(1, 1), b3 + hstep, voffB);
            PG8_WAIT_V(6); PG8_BAR; PG8_MMA(1, 1, At, B1); PG8_BAR;
            }
        }
        if constexpr (ALIGN_EPI) { if (wr == 0) PG8_BAR; }
        if constexpr (!Epi::AFTER_DRAIN) { E(acc, cur, wr, wc, fr, fq, lds, wid, ui);
#ifdef PROBE_EPI
            asm volatile("" ::: "memory"); E(acc, cur, wr, wc, fr, fq, lds, wid, ui);
#endif
            S.done(cur); }
        if (!has_next) break;
#pragma unroll
        for (int a = 0; a < 2; ++a)
#pragma unroll
            for (int b = 0; b < 2; ++b)
#pragma unroll
                for (int m = 0; m < 4; ++m)
#pragma unroll
                    for (int n = 0; n < 2; ++n) acc[a][b][m][n] = (f32x4){0.f, 0.f, 0.f, 0.f};
        cur = nxt; cA = nA; cB = nB; ++ui;
        if constexpr (ALIGN_EPI) { if (wr == 1) PG8_BAR; }
    }
    PG8_WAIT_V(0);
    if constexpr (!ALIGN_EPI) { if (wr == 0) PG8_BAR; }
    PG8_BAR;
    if constexpr (Epi::AFTER_DRAIN) { E.fused(acc, cur, wr, wc, fr, fq, lds, wid, lane); S.done(cur); }
#undef PG8_SA
#undef PG8_SB
#undef PG8_STAGE
#undef PG8_LDA
#undef PG8_LDB
#undef PG8_MMA
#undef PG8_WAIT_V
#undef PG8_WAIT_L
#undef PG8_BAR
#undef PG8_SCHED
#undef PG8_PF
#undef PG8_WAIT_VL
}
}

namespace att {
#define ALAS __attribute__((address_space(3)))
typedef unsigned short bf16;
typedef short bf16x8 __attribute__((ext_vector_type(8)));
typedef short s16x4 __attribute__((ext_vector_type(4)));
typedef float f32x16 __attribute__((ext_vector_type(16)));
typedef float f32x4 __attribute__((ext_vector_type(4)));
typedef unsigned u32x4 __attribute__((ext_vector_type(4)));
constexpr int SHM_V = 16384, SHM_K = 16384;
#define KSWZ(row, colB) ((row) * 256 + ((colB) ^ (((row) & 7) << 4)))
#define SBAR() __builtin_amdgcn_sched_barrier(0)
__device__ __forceinline__ int v_st(int k, int c) { const int kk = (k & ~0xC) | ((k & 4) << 1) | ((k & 8) >> 1); return ((kk >> 3) * 4 + (c >> 5)) * 512 + ((kk & 7) * 32 + (c & 31)) * 2; }
__device__ __forceinline__ int v_rd_base(int lane) { return ((lane & 3) << 3) | (((lane >> 2) & 3) << 6) | (((lane >> 4) & 1) << 5) | (((lane >> 5) & 1) << 8); }
__device__ __forceinline__ int crow(int r, int hi) { return (r & 3) + 8 * (r >> 2) + 4 * hi; }
__device__ __forceinline__ unsigned cvtpk(float lo, float hi) { unsigned r; asm volatile("v_cvt_pk_bf16_f32 %0, %1, %2" : "=v"(r) : "v"(lo), "v"(hi)); return r; }

__device__ __forceinline__ void qkt(f32x16& p0, f32x16& p1, const ALAS char* Kb, int r32, int hi, const bf16x8* qr) {
    p0 = f32x16{}; p1 = f32x16{};
    const ALAS char* kb[4];
#pragma unroll
    for (int dd = 0; dd < 4; ++dd) kb[dd] = Kb + KSWZ(r32, (dd * 16 + hi * 8) * 2);
#ifdef ATT_PRIO
    __builtin_amdgcn_s_setprio(1);
#endif
#pragma unroll
    for (int d0 = 0; d0 < 8; ++d0) { const ALAS char* a = kb[d0 & 3] + (d0 >> 2) * 128;
        bf16x8 b0 = *reinterpret_cast<const ALAS bf16x8*>(a);
        bf16x8 b1 = *reinterpret_cast<const ALAS bf16x8*>(a + 32 * 256);
        p0 = __builtin_amdgcn_mfma_f32_32x32x16_bf16(b0, qr[d0], p0, 0, 0, 0);
        p1 = __builtin_amdgcn_mfma_f32_32x32x16_bf16(b1, qr[d0], p1, 0, 0, 0); }
#ifdef ATT_PRIO
    __builtin_amdgcn_s_setprio(0);
#endif
}
__device__ __forceinline__ void pv_tile(f32x16* o, int vb, bf16x8 pa0, bf16x8 pa1, bf16x8 pa2, bf16x8 pa3) {
#define TRRD(dst, off) asm volatile("ds_read_b64_tr_b16 %0, %1 offset:%2" : "=&v"(dst) : "v"(vb), "i"(off) : "memory")
#define PV_D0(d0) do { s16x4 l0, l1, l2, l3, h0, h1, h2, h3; constexpr int b_ = (d0) * 512; \
        TRRD(l0, b_); TRRD(h0, b_ + 2048); TRRD(l1, b_ + 4096); TRRD(h1, b_ + 6144); TRRD(l2, b_ + 8192); TRRD(h2, b_ + 10240); TRRD(l3, b_ + 12288); TRRD(h3, b_ + 14336); \
        asm volatile("s_waitcnt lgkmcnt(0)" ::: "memory"); SBAR(); \
        o[d0] = __builtin_amdgcn_mfma_f32_32x32x16_bf16(pa0, (bf16x8){l0[0], l0[1], l0[2], l0[3], h0[0], h0[1], h0[2], h0[3]}, o[d0], 0, 0, 0); \
        o[d0] = __builtin_amdgcn_mfma_f32_32x32x16_bf16(pa1, (bf16x8){l1[0], l1[1], l1[2], l1[3], h1[0], h1[1], h1[2], h1[3]}, o[d0], 0, 0, 0); \
        o[d0] = __builtin_amdgcn_mfma_f32_32x32x16_bf16(pa2, (bf16x8){l2[0], l2[1], l2[2], l2[3], h2[0], h2[1], h2[2], h2[3]}, o[d0], 0, 0, 0); \
        o[d0] = __builtin_amdgcn_mfma_f32_32x32x16_bf16(pa3, (bf16x8){l3[0], l3[1], l3[2], l3[3], h3[0], h3[1], h3[2], h3[3]}, o[d0], 0, 0, 0); } while (0)
#ifdef ATT_PRIO
    __builtin_amdgcn_s_setprio(1);
#endif
    PV_D0(0); PV_D0(1); PV_D0(2); PV_D0(3);
#ifdef ATT_PRIO
    __builtin_amdgcn_s_setprio(0);
#endif
#undef PV_D0
#undef TRRD
}
__device__ __forceinline__ float swap_sum(float x) { auto rr = __builtin_amdgcn_permlane32_swap(__float_as_uint(x), __float_as_uint(x), false, false); return __uint_as_float(rr[0]) + __uint_as_float(rr[1]); }
__device__ __forceinline__ float swap_max(float x) { auto rr = __builtin_amdgcn_permlane32_swap(__float_as_uint(x), __float_as_uint(x), false, false); return fmaxf(__uint_as_float(rr[0]), __uint_as_float(rr[1])); }
#define PK4(P, B_, OUT) do { unsigned a0 = cvtpk(P[B_+0], P[B_+1]), a1 = cvtpk(P[B_+2], P[B_+3]); \
        unsigned b0 = cvtpk(P[B_+4], P[B_+5]), b1 = cvtpk(P[B_+6], P[B_+7]); \
        auto r0 = __builtin_amdgcn_permlane32_swap(a0, b0, false, false); auto r1 = __builtin_amdgcn_permlane32_swap(a1, b1, false, false); \
        u32x4 w = {r0[0], r1[0], r0[1], r1[1]}; OUT = *reinterpret_cast<bf16x8*>(&w); } while (0)

struct UnitP { const GAS bf16* Q; const GAS bf16* K; const GAS bf16* V; size_t pitch; GAS bf16* O; size_t opitch; GAS float* lse; int lse_stride; int P0; float slope2; };
struct Seam { bf16x8 qr[8]; bf16x8 s0, s1, s2, s3; };
template <int MODE> __device__ __forceinline__ int first_tile(int P0) { if (MODE == 0) { const int lowk = P0 - 128; return lowk > 0 ? lowk / 64 : 0; } else return (P0 + 254) / 64; }
template <int MODE> __device__ __forceinline__ void attn_prefetch(const UnitP& u, Seam& S, int tid) {
    const int wid = __builtin_amdgcn_readfirstlane(tid >> 6), lane = tid & 63, r32 = lane & 31, hi = lane >> 5;
    const int qpos = u.P0 + 32 * wid + r32, sr = tid >> 4, sc = (tid & 15) * 8, kb = first_tile<MODE>(u.P0) * 64;
#pragma unroll
    for (int d0 = 0; d0 < 8; ++d0) S.qr[d0] = *(const GAS bf16x8*)(u.Q + (size_t)qpos * u.pitch + d0 * 16 + hi * 8);
    const GAS bf16* k_ = u.K + (size_t)(kb + sr) * u.pitch + sc; const GAS bf16* v_ = u.V + (size_t)(kb + sr) * u.pitch + sc;
    S.s0 = *(const GAS bf16x8*)k_; S.s1 = *(const GAS bf16x8*)(k_ + 32 * u.pitch); S.s2 = *(const GAS bf16x8*)v_; S.s3 = *(const GAS bf16x8*)(v_ + 32 * u.pitch);
}
template <int MODE>
__device__ __forceinline__ void attn_unit(ALAS char* lds, const UnitP& u, bool has_next, const UnitP& nx, Seam& S) {
    const GAS bf16* Kp = u.K; const GAS bf16* Vp = u.V; const size_t pitch = u.pitch; GAS bf16* Op = u.O; const size_t opitch = u.opitch; GAS float* lsep = u.lse; const int lse_stride = u.lse_stride, P0 = u.P0; const float slope2 = u.slope2;
    const int tid = opaque_tid(), wid = __builtin_amdgcn_readfirstlane(tid >> 6), lane = tid & 63, r32 = lane & 31, hi = lane >> 5;
    const int qlo = P0 + 32 * wid, qpos = qlo + r32;
    ALAS char* V_lds = lds; ALAS char* K_lds = lds + 2 * SHM_V;
    ALAS float* wsf = (ALAS float*)(lds + 2 * SHM_V + 2 * SHM_K) + wid * 64; ALAS float* li_l = wsf; ALAS float* al_l = wsf + 32;
    const int sr = tid >> 4, sc = (tid & 15) * 8, vst0 = v_st(sr, sc), vst1 = v_st(32 + sr, sc), kws = KSWZ(sr, sc * 2);
    const int vb0 = (int)(unsigned)(size_t)V_lds + v_rd_base(lane);
    int NT, tbase, tstep;
    if (MODE == 0) { const int jlo = first_tile<0>(P0); const int jhi = (P0 + 255) / 64; NT = jhi - jlo + 1; tbase = jlo; tstep = 1; }
    else { const int jhi = first_tile<1>(P0); NT = jhi + 1; tbase = jhi; tstep = -1; }
    bf16x8 (&qr)[8] = S.qr;
    bf16x8& sa0 = S.s0; bf16x8& sa1 = S.s1; bf16x8& sa2 = S.s2; bf16x8& sa3 = S.s3;
#define SLOAD(S_, kb_) do { const GAS bf16* k_ = Kp + (size_t)((kb_) + sr) * pitch + sc; const GAS bf16* v_ = Vp + (size_t)((kb_) + sr) * pitch + sc; \
        S_##0 = *(const GAS bf16x8*)k_; S_##1 = *(const GAS bf16x8*)(k_ + 32 * pitch); S_##2 = *(const GAS bf16x8*)v_; S_##3 = *(const GAS bf16x8*)(v_ + 32 * pitch); } while (0)
#define SWRITE(S_, bf_) do { *(ALAS bf16x8*)(K_lds + (bf_) * SHM_K + kws) = S_##0; *(ALAS bf16x8*)(K_lds + (bf_) * SHM_K + kws + 32 * 256) = S_##1; \
        *(ALAS bf16x8*)(V_lds + (bf_) * SHM_V + vst0) = S_##2; *(ALAS bf16x8*)(V_lds + (bf_) * SHM_V + vst1) = S_##3; } while (0)
#define TILE(i_) ((tbase + tstep * (i_)) * 64)
    SWRITE(sa, 0);
    __syncthreads();
    f32x16 o[4] = {};
    float m_reg = -1e30f, l_reg = 0.f, carry = 1.f;
    ALAS int* flg = (ALAS int*)(lds + 2 * SHM_V + 2 * SHM_K + 2048);
    bool alive = true;
    auto step = [&](const int i, const int buf) __attribute__((always_inline)) {
        const int kb = TILE(i);
        alive = (MODE == 0) ? true : (__any(carry != 0.f) != 0);
        const bool act = (MODE == 0) ? (kb <= qlo + 31 && kb + 63 >= qlo - 128) : (kb < qlo + 31 && alive);
        if (act) {
            f32x16 p0, p1; bf16x8 pa0, pa1, pa2, pa3;
            qkt(p0, p1, K_lds + buf * SHM_K, r32, hi, qr);
#if defined(ATT_PROBE) && ATT_PROBE == 1
            asm volatile("" : "+v"(p0), "+v"(p1)); qkt(p0, p1, K_lds + buf * SHM_K, r32, hi, qr);
#endif
            const int dqb = qpos - kb - 4 * hi;
            if (MODE == 0) {
                const float NEG = -__builtin_inff();
#pragma unroll
                for (int r = 0; r < 16; ++r) { const int c = (r & 3) + 8 * (r >> 2); const int d0_ = dqb - c, d1_ = d0_ - 32;
                    p0[r] = ((unsigned)d0_ <= 128u) ? fmaf(-slope2, (float)d0_, p0[r]) : NEG;
                    p1[r] = ((unsigned)d1_ <= 128u) ? fmaf(-slope2, (float)d1_, p1[r]) : NEG; }
                float pmax = p0[0];
#pragma unroll
                for (int r = 1; r < 16; ++r) pmax = fmaxf(pmax, p0[r]);
#pragma unroll
                for (int r = 0; r < 16; ++r) pmax = fmaxf(pmax, p1[r]);
                pmax = swap_max(pmax);
                const float mn = fmaxf(m_reg, pmax), alpha = __builtin_amdgcn_exp2f(m_reg - mn); m_reg = mn;
                float ps = 0.f;
#pragma unroll
                for (int r = 0; r < 16; ++r) { p0[r] = __builtin_amdgcn_exp2f(p0[r] - mn); ps += p0[r]; }
#pragma unroll
                for (int r = 0; r < 16; ++r) { p1[r] = __builtin_amdgcn_exp2f(p1[r] - mn); ps += p1[r]; }
                ps = swap_sum(ps);
                l_reg = l_reg * alpha + ps;
                if (__any(alpha < 1.f)) { if (hi == 0) al_l[r32] = alpha; asm volatile("s_waitcnt lgkmcnt(0)" ::: "memory");
#pragma unroll
                    for (int d_ = 0; d_ < 4; ++d_)
#pragma unroll
                        for (int r = 0; r < 16; ++r) o[d_][r] *= al_l[crow(r, hi)]; }
            } else {
                const bool need_mask = kb + 63 >= qlo;
                f32x16 U0, U1;
#pragma unroll
                for (int r = 0; r < 16; ++r) { U0[r] = __builtin_amdgcn_rcpf(1.f + __builtin_amdgcn_exp2f(p0[r])); U1[r] = __builtin_amdgcn_rcpf(1.f + __builtin_amdgcn_exp2f(p1[r])); }
                if (need_mask) {
#pragma unroll
                    for (int r = 0; r < 16; ++r) { const int c = (r & 3) + 8 * (r >> 2); if (dqb - c <= 0) U0[r] = 1.f; if (dqb - c - 32 <= 0) U1[r] = 1.f; } }
#pragma unroll
                for (int r = 0; r < 16; ++r) { p0[r] = 1.f - U0[r]; p1[r] = 1.f - U1[r]; }
                float T[8], part[8];
#pragma unroll
                for (int G = 0; G < 8; ++G) { const int b = 4 * (G & 3); float g;
                    if (G < 4) { const float t2 = U0[b + 3], t1 = t2 * U0[b + 2], t0 = t1 * U0[b + 1]; g = t0 * U0[b]; U0[b + 2] = t2; U0[b + 1] = t1; U0[b] = t0; }
                    else       { const float t2 = U1[b + 3], t1 = t2 * U1[b + 2], t0 = t1 * U1[b + 1]; g = t0 * U1[b]; U1[b + 2] = t2; U1[b + 1] = t1; U1[b] = t0; }
                    auto rr = __builtin_amdgcn_permlane32_swap(__float_as_uint(g), __float_as_uint(g), false, false);
                    const float glo = __uint_as_float(rr[0]), ghi = __uint_as_float(rr[1]);
                    T[G] = glo * ghi; part[G] = hi ? 1.f : ghi; }
                float run = carry;
#pragma unroll
                for (int G = 7; G >= 0; --G) { const int b = 4 * (G & 3); const float F = run * part[G];
                    if (G < 4) { p0[b + 3] *= F; p0[b + 2] *= F * U0[b + 2]; p0[b + 1] *= F * U0[b + 1]; p0[b] *= F * U0[b]; }
                    else       { p1[b + 3] *= F; p1[b + 2] *= F * U1[b + 2]; p1[b + 1] *= F * U1[b + 1]; p1[b] *= F * U1[b]; }
                    run *= T[G]; }
                carry = run;
            }
            PK4(p0, 0, pa0); PK4(p0, 8, pa1); PK4(p1, 0, pa2); PK4(p1, 8, pa3);
            SBAR();
            pv_tile(o, vb0 + buf * SHM_V, pa0, pa1, pa2, pa3);
#if defined(ATT_PROBE) && ATT_PROBE == 2
            { bf16x8 z = {}; asm volatile("" : "+v"(z)); pv_tile(o, vb0 + buf * SHM_V, z, z, z, z); }
#endif
        }
    };
#if defined(ATT_PROBE) && ATT_PROBE == 3
#define VOTE_X() __syncthreads()
#else
#define VOTE_X()
#endif
#define VOTE(i_) ({ VOTE_X(); bool go_ = true; if (MODE == 1) { if (lane == 0) flg[((i_) & 1) * 8 + wid] = alive ? 1 : 0; __syncthreads(); go_ = __any(flg[((i_) & 1) * 8 + (lane & 7)] != 0) != 0; } else __syncthreads(); go_; })
    for (int i = 0; i < NT; ++i) {
        if (i + 1 < NT) SLOAD(sa, TILE(i + 1));
        step(i, i & 1);
        if (i + 1 < NT) SWRITE(sa, (i & 1) ^ 1);
        if (!VOTE(i)) break;
    }
    if (has_next) attn_prefetch<MODE>(nx, S, tid);
#undef VOTE
#undef TILE
#undef SLOAD
#undef SWRITE
    float rli[16];
    if (MODE == 0) {
        if (hi == 0) { li_l[r32] = l_reg; lsep[(size_t)qpos * lse_stride] = m_reg + __builtin_amdgcn_logf(l_reg); }
        asm volatile("s_waitcnt lgkmcnt(0)" ::: "memory");
#pragma unroll
        for (int r = 0; r < 16; ++r) rli[r] = __builtin_amdgcn_rcpf(li_l[crow(r, hi)]);
    } else {
#pragma unroll
        for (int r = 0; r < 16; ++r) rli[r] = 1.f;
    }
    GAS bf16* Ow = Op + (size_t)qlo * opitch;
#if defined(ATT_PROBE) && ATT_PROBE == 4
    for (int rep_ = 0; rep_ < 2; ++rep_)
#endif
    {
        ALAS unsigned short* ot = (ALAS unsigned short*)(lds + wid * 8192);
#pragma unroll
        for (int r = 0; r < 16; ++r) { const int orow = crow(r, hi);
#pragma unroll
            for (int d0 = 0; d0 < 4; ++d0) { const float v = o[d0][r] * rli[r]; ot[orow * 128 + d0 * 32 + r32] = (unsigned short)cvtpk(v, v); } }
        asm volatile("s_waitcnt lgkmcnt(0)" ::: "memory");
#pragma unroll
        for (int i = 0; i < 8; ++i) { const int row = i * 4 + (lane >> 4), ch = lane & 15;
            const u32x4 w = *(const ALAS u32x4*)(ot + row * 128 + ch * 8);
            *(GAS u32x4*)(Ow + (size_t)row * opitch + ch * 8) = w; }
    }
    __syncthreads();
}
}

#ifndef MK_N_LAUNCHES
#define MK_N_LAUNCHES 1
#endif
constexpr int NWAVES = 8;
constexpr int BATCH = 4, SEQ = 4096, DM = 2048, DFF = 8192, M = BATCH * SEQ;
constexpr int NIN0 = 5120, NQKV = 6144;
constexpr float RMS_EPS = 1e-6f, LN_EPS = 1e-5f;
constexpr float QSCALE = 0.08838834764831845f * 1.4426950408889634f;
constexpr size_t MiB = 1u << 20;
constexpr size_t WS_WIN = 2 * MiB, WS_WOUT = 22 * MiB, WS_W1_0 = 30 * MiB, WS_W2_0 = 62 * MiB;
constexpr size_t WS_SBIN = 2 * MiB, WS_SBOUT = 26 * MiB, WS_W1_1 = 34 * MiB, WS_W2_1 = 66 * MiB;
constexpr size_t WS_RX = 1 * MiB;
constexpr size_t WS_XR = 98 * MiB;
constexpr size_t WS_YH = 162 * MiB;
constexpr size_t WS_BIG = 226 * MiB;
constexpr size_t WS_END = 482 * MiB;
constexpr int LDS_BYTES = 147456;
constexpr int N_PHASES = 16;

#define LAS __attribute__((address_space(3)))
typedef unsigned short bf16;
typedef unsigned v4u __attribute__((ext_vector_type(4)));
typedef unsigned v2u __attribute__((ext_vector_type(2)));
typedef float f32x4 __attribute__((ext_vector_type(4)));
typedef short bf16x8 __attribute__((ext_vector_type(8)));
#define LDS_WAIT() asm volatile("s_waitcnt lgkmcnt(0)" ::: "memory")
__device__ __forceinline__ unsigned f2bf(float f) { unsigned u = __builtin_bit_cast(unsigned, f); return (u + 0x7fffu + ((u >> 16) & 1u)) >> 16; }
__device__ __forceinline__ unsigned pk2(float lo, float hi) { return f2bf(lo) | (f2bf(hi) << 16); }
__device__ __forceinline__ float bflo(unsigned w) { return __builtin_bit_cast(float, w << 16); }
__device__ __forceinline__ float bfhi(unsigned w) { return __builtin_bit_cast(float, w & 0xffff0000u); }
__device__ __forceinline__ float wave_sum(float v) {
#pragma unroll
    for (int o = 1; o < 64; o <<= 1) v += __shfl_xor(v, o);
    return v;
}
__device__ __forceinline__ void p0_transpose_item(const float* W, int K, int N, GAS bf16* WT, LAS float* scr, int item, int lane, const float* gk = nullptr) {
    const int nblk = N / 64, kb = item / nblk, nb = item % nblk, k0 = 64 * kb, n0 = 64 * nb;
    const int kl = lane >> 4, n4 = (lane & 15) * 4;
    f32x4 v[16];
#pragma unroll
    for (int i = 0; i < 16; ++i) v[i] = __builtin_nontemporal_load((const f32x4*)(W + (size_t)(k0 + 4 * i + kl) * N + n0 + n4));
#pragma unroll
    for (int i = 0; i < 16; ++i) { const float gg = gk ? gk[k0 + 4 * i + kl] : 1.f; LAS float* s = scr + (4 * i + kl) * 65 + n4; s[0] = v[i].x * gg; s[1] = v[i].y * gg; s[2] = v[i].z * gg; s[3] = v[i].w * gg; }
    LDS_WAIT(); asm volatile("" ::: "memory");
    const int c = lane & 7;
#pragma unroll
    for (int j = 0; j < 8; ++j) { const int n = (lane >> 3) + 8 * j; const LAS float* s = scr + (8 * c) * 65 + n;
        v4u o; o.x = pk2(s[0 * 65], s[1 * 65]); o.y = pk2(s[2 * 65], s[3 * 65]); o.z = pk2(s[4 * 65], s[5 * 65]); o.w = pk2(s[6 * 65], s[7 * 65]);
#ifdef CONV_NT
        __builtin_nontemporal_store(o, (GAS v4u*)(WT + (size_t)(n0 + n) * K + k0 + 8 * c)); }
#else
        *(GAS v4u*)(WT + (size_t)(n0 + n) * K + k0 + 8 * c) = o; }
#endif
    LDS_WAIT(); asm volatile("" ::: "memory");
}
#define XB_TMO      128
#define XB_XCNT(j)  (256  + 64 * (j))
#define XB_XSUB(j)  (1280 + 64 * (j))
#define XB_XGEN(j)  (2304 + 64 * (j))
#define XB_TOP      3328
#define XB_TOPGEN   3392
#define XCD_BAR_WORDS 3456
#define XB_SPIN_CAP (1u << 18)

__device__ __forceinline__ unsigned xb_ld(unsigned* p)              { return __hip_atomic_load(p, __ATOMIC_RELAXED, __HIP_MEMORY_SCOPE_AGENT); }
__device__ __forceinline__ unsigned xb_add(unsigned* p, unsigned v) { return __hip_atomic_fetch_add(p, v, __ATOMIC_RELAXED, __HIP_MEMORY_SCOPE_AGENT); }
__device__ __forceinline__ unsigned xb_xcc_id() { return (unsigned)__builtin_amdgcn_s_getreg((3 << 11) | 20) & 0xFu; }
#define XB_SPIN(cond, bar) do { unsigned _sp = 0; while (cond) { __builtin_amdgcn_s_sleep(1); \
    if ((++_sp & 255u) == 0u) { if (xb_ld(&(bar)[XB_TMO])) break; if (_sp > XB_SPIN_CAP) { atomicAdd(&(bar)[XB_TMO], 1u); break; } } } } while (0)

struct XcdBarrier {
    unsigned* bar; unsigned x;
    volatile LAS unsigned* st;
};

__device__ __forceinline__ XcdBarrier xcd_barrier_post(unsigned* bar, volatile LAS unsigned* st) {
    XcdBarrier b; b.bar = bar; b.x = xb_xcc_id(); b.st = st;
    if (threadIdx.x == 0) (void)xb_add(&bar[XB_XCNT(b.x)], 1u);
    return b;
}
__device__ __forceinline__ void xcd_barrier_complete(unsigned* bar, unsigned x, unsigned& nloc, unsigned& nx) {
    const unsigned G = gridDim.x * gridDim.y * gridDim.z;
    unsigned sum, cnt, mine, sp = 0u;
    for (;;) {
        sum = 0u; cnt = 0u; mine = 0u;
#pragma unroll
        for (unsigned j = 0; j < 16; ++j) { const unsigned c = xb_ld(&bar[XB_XCNT(j)]); sum += c; cnt += (c > 0u) ? 1u : 0u; mine = (j == x) ? c : mine; }
        if (sum == G) break;
        __builtin_amdgcn_s_sleep(1);
        if ((++sp & 255u) == 0u) { if (xb_ld(&bar[XB_TMO])) break; if (sp > XB_SPIN_CAP) { atomicAdd(&bar[XB_TMO], 1u); break; } }
    }
    nloc = mine > 0u ? mine : 1u; nx = cnt > 0u ? cnt : 1u;
}

__device__ __forceinline__ void xcd_barrier(const XcdBarrier& b) {
    asm volatile("s_waitcnt vmcnt(0)" ::: "memory");
    __syncthreads();
    if (threadIdx.x == 0) {
        unsigned* bar = b.bar;
        __builtin_amdgcn_s_waitcnt(0);
        unsigned nloc = b.st[0], nx = b.st[1];
        if (nloc == 0u) { xcd_barrier_complete(bar, b.x, nloc, nx); b.st[0] = nloc; b.st[1] = nx; }
        const unsigned old = xb_add(&bar[XB_XSUB(b.x)], 1u);
        const unsigned gen = old / nloc;
        if (old + 1u == (gen + 1u) * nloc) {
            __builtin_amdgcn_fence(__ATOMIC_RELEASE, "agent");
            asm volatile("s_waitcnt vmcnt(0)" ::: "memory");
            const unsigned og = xb_add(&bar[XB_TOP], 1u);
            const unsigned tg = og / nx;
            if (og + 1u == (tg + 1u) * nx) xb_add(&bar[XB_TOPGEN], 1u);
            else XB_SPIN(xb_ld(&bar[XB_TOPGEN]) == tg, bar);
            __builtin_amdgcn_fence(__ATOMIC_ACQUIRE, "agent");
            xb_add(&bar[XB_XGEN(b.x)], 1u);
            asm volatile("s_waitcnt vmcnt(0)" ::: "memory");
        } else {
            XB_SPIN(xb_ld(&bar[XB_XGEN(b.x)]) == gen, bar);
            __builtin_amdgcn_fence(__ATOMIC_ACQUIRE, "agent");
            asm volatile("s_waitcnt vmcnt(0)" ::: "memory");
        }
    }
    __syncthreads();
}

struct Args { const float* in[15]; float* out; unsigned char* ws; int ph_lo, ph_hi; };

__global__ void __launch_bounds__(NWAVES * 64, 2) mk_fwd(Args args) {
    extern __shared__ __attribute__((aligned(16))) unsigned char lds_raw[];
    LAS unsigned char* lds = (LAS unsigned char*)lds_raw;
#ifdef LAYOUT_SHIFT
    asm volatile("s_nop 0\n s_nop 0\n s_nop 0\n s_nop 0\n s_nop 0\n s_nop 0\n s_nop 0\n s_nop 0\n s_nop 0\n s_nop 0\n s_nop 0\n s_nop 0\n s_nop 0\n s_nop 0\n s_nop 0\n s_nop 0\n s_nop 0");
#endif
    const int G = gridDim.x, bx = blockIdx.x;
    const int vcu = (G % 8 == 0) ? (bx % 8) * (G / 8) + bx / 8 : bx;
    volatile LAS unsigned* xst = (volatile LAS unsigned*)(lds + 139264);
    if (threadIdx.x < 2) xst[threadIdx.x] = 0u;
    __syncthreads();
    unsigned* barw = (unsigned*)args.ws;
    XcdBarrier xbar; xbar.bar = barw; xbar.x = 0; xbar.st = xst;
    const float* x_in = args.in[0];
    float* out = args.out;

#ifdef TEST_PH
    { const int ph = TEST_PH;
#else
    for (int ph = args.ph_lo; ph < args.ph_hi; ++ph) {
#endif
#ifndef PROBE_MASK
#define PROBE_MASK 0
#endif
        for (int rep = 0; rep < (((PROBE_MASK >> ph) & 1) ? 2 : 1); ++rep) {
        const int tid = opaque_tid(), lane = tid & 63, wave = __builtin_amdgcn_readfirstlane(tid >> 6);
        const int gw = vcu * NWAVES + wave, NGW = G * NWAVES;
        int vq = vcu; asm volatile("" : "+s"(vq));
        unsigned long long wsv = (unsigned long long)args.ws; asm volatile("" : "+s"(wsv));
        GAS unsigned char* ws = (GAS unsigned char*)wsv;
        GAS bf16* YH = (GAS bf16*)(ws + WS_YH);
        GAS bf16* Z = (GAS bf16*)(ws + WS_BIG);
        GAS bf16* CAT = (GAS bf16*)(ws + WS_BIG + 160 * MiB);
        GAS float* LSE = (GAS float*)(ws + WS_BIG + 224 * MiB);
        GAS bf16* OB4 = (GAS bf16*)(ws + WS_YH);
        GAS bf16* OB16 = (GAS bf16*)(ws + WS_YH + 32 * MiB);
        GAS bf16* ABUF = (GAS bf16*)(ws + WS_BIG);
        GAS bf16* QKV = (GAS bf16*)(ws + WS_BIG);
        GAS bf16* OBUF = (GAS bf16*)(ws + WS_BIG + 192 * MiB);
        if (ph == 0) {
            if (bx == 0) for (int i = tid; i < XCD_BAR_WORDS; i += NWAVES * 64) barw[i] = 0u;
            LAS float* scr = (LAS float*)(lds + wave * 16640);
            constexpr int I0 = (DM / 64) * (NIN0 / 64), I1 = (DM / 64) * (DM / 64), I4 = (DM / 64) * (DFF / 64), I5 = (DFF / 64) * (DM / 64);
            constexpr int NITEMS = I0 + I1 + I4 + I5;
            for (int it = gw; it < NITEMS; it += NGW) {
                int r = it;
                if (r < I0) { p0_transpose_item(args.in[5], DM, NIN0, (GAS bf16*)(ws + WS_WIN), scr, r, lane, args.in[1]); continue; } r -= I0;
                if (r < I1) { p0_transpose_item(args.in[10], DM, DM, (GAS bf16*)(ws + WS_WOUT), scr, r, lane); continue; } r -= I1;
                if (r < I4) { p0_transpose_item(args.in[13], DM, DFF, (GAS bf16*)(ws + WS_W1_0), scr, r, lane, args.in[3]); continue; } r -= I4;
                p0_transpose_item(args.in[14], DFF, DM, (GAS bf16*)(ws + WS_W2_0), scr, r, lane);
            }
            GAS bf16* XR0 = (GAS bf16*)(ws + WS_XR); GAS float* RX0 = (GAS float*)(ws + WS_RX);
            for (int m = gw; m < M; m += NGW) {
                const float* xr = x_in + (size_t)m * DM + lane * 8; f32x4 v[8]; float ss = 0.f;
#pragma unroll
                for (int j = 0; j < 4; ++j) { v[2 * j] = __builtin_nontemporal_load((const f32x4*)(xr + 512 * j)); v[2 * j + 1] = __builtin_nontemporal_load((const f32x4*)(xr + 512 * j + 4)); }
#pragma unroll
                for (int j = 0; j < 8; ++j) ss += (v[j].x * v[j].x + v[j].y * v[j].y) + (v[j].z * v[j].z + v[j].w * v[j].w);
                const float rs = 1.f / sqrtf(wave_sum(ss) * (1.f / DM) + RMS_EPS);
                if (lane == 0) RX0[m] = rs;
#pragma unroll
                for (int j = 0; j < 4; ++j) { const f32x4 a = v[2 * j], b = v[2 * j + 1];
                    v4u o; o.x = pk2(a.x, a.y); o.y = pk2(a.z, a.w); o.z = pk2(b.x, b.y); o.w = pk2(b.z, b.w);
                    *(GAS v4u*)(XR0 + (size_t)m * DM + lane * 8 + 512 * j) = o; }
            }
        } else if (ph == 1 || ph == 4 || ph == 6 || ph == 7 || ph == 9 || ph == 11 || ph == 13 || ph == 14) {
            pg8::Gemm g; pg8::EpiGen E; E.gelu_tiles = 0; E.sc_lo = 0; E.sc_hi = 0; E.sc = 1.f; E.relu2 = 0; E.rs = nullptr;
            const GAS bf16* XRA = (const GAS bf16*)(ws + WS_XR); const GAS float* RXA = (const GAS float*)(ws + WS_RX);
            if (ph == 1)       { g = pg8::Gemm{XRA, (const GAS bf16*)(ws + WS_WIN), M, NIN0, DM}; E.rs = RXA; E.O = Z; E.ldc = NIN0; E.gelu_tiles = 8; E.sc_lo = 8; E.sc_hi = 12; E.sc = QSCALE; }
            else if (ph == 4)  { g = pg8::Gemm{CAT, (const GAS bf16*)(ws + WS_WOUT), M, DM, DM}; E.O = YH; E.ldc = DM; }
            else if (ph == 6)  { g = pg8::Gemm{XRA, (const GAS bf16*)(ws + WS_W1_0), M, DFF, DM}; E.rs = RXA; E.O = ABUF; E.ldc = DFF; E.relu2 = 1; }
            else if (ph == 7)  { g = pg8::Gemm{ABUF, (const GAS bf16*)(ws + WS_W2_0), M, DM, DFF}; E.O = YH; E.ldc = DM; }
            else if (ph == 9)  { g = pg8::Gemm{XRA, (const GAS bf16*)(ws + WS_SBIN), M, NQKV, DM}; E.rs = RXA; E.O = QKV; E.ldc = NQKV; E.sc_lo = 0; E.sc_hi = 8; E.sc = QSCALE; }
            else if (ph == 11) { g = pg8::Gemm{OBUF, (const GAS bf16*)(ws + WS_SBOUT), M, DM, DM}; E.O = YH; E.ldc = DM; }
            else if (ph == 13) { g = pg8::Gemm{XRA, (const GAS bf16*)(ws + WS_W1_1), M, DFF, DM}; E.rs = RXA; E.O = ABUF; E.ldc = DFF; E.relu2 = 1; }
            else               { g = pg8::Gemm{ABUF, (const GAS bf16*)(ws + WS_W2_1), M, DM, DFF}; E.O = YH; E.ldc = DM; }
            #ifndef WGM_FFN1
#define WGM_FFN1 4
#endif
#ifndef WGM_IN
#define WGM_IN 4
#endif
            #ifdef ALT_XCD_MAP
            const int cmap = (bx / 32) + (bx % 32) * 8;
#else
            const int cmap = bx;
#endif
            #ifndef REV_MASK
#define REV_MASK 16512
#endif
            pg8::StaticOrder S; S.init(g.M, g.N, G, cmap, (g.N == DFF) ? WGM_FFN1 : ((g.N == DM) ? 4 : WGM_IN), (REV_MASK >> ph) & 1);
            #ifndef GEMM_ALIGN
#define GEMM_ALIGN true
#endif
#ifndef GEMM_SP2
#define GEMM_SP2 true
#endif
            pg8::gemm_phase<pg8::EpiGen, pg8::StaticOrder, GEMM_ALIGN, GEMM_SP2>(lds, g, S, E);
        } else if (ph == 2) {
            auto mk = [&](int it) __attribute__((always_inline)) { att::UnitP u;
                const int br = it / 512, rem = it % 512, b = rem / 128, h = (rem / 16) % 8, w = rem % 16;
                const int r = (br == 0) ? 1 : (br == 1 ? 4 : 16), nqb = 16 / r, rho = w / nqb, qb = w % nqb;
                u.Q = Z + (size_t)(b * SEQ + rho) * NIN0 + 2048 + h * 128; u.K = u.Q + 1024; u.V = u.Q + 2048; u.pitch = (size_t)r * NIN0;
                if (br == 0) { u.O = CAT + (size_t)(b * SEQ + rho) * DM + 1024 + h * 128; u.opitch = (size_t)r * DM; }
                else { u.O = (br == 1 ? OB4 : OB16) + (size_t)(b * SEQ + rho) * 1024 + h * 128; u.opitch = (size_t)r * 1024; }
                u.lse = LSE + (size_t)br * M * 8 + (size_t)(b * SEQ + rho) * 8 + h; u.lse_stride = r * 8; u.P0 = qb * 256;
                u.slope2 = exp2f(-(float)(h + 1)) * (float)r * 1.4426950408889634f; return u; };
            att::Seam S; att::UnitP cur = mk(vq < 1536 ? vq : 1535);
            att::attn_prefetch<0>(cur, S, tid);
            for (int it = vq; it < 1536; it += G) { const bool hn = it + G < 1536; const att::UnitP nx = hn ? mk(it + G) : cur;
                att::attn_unit<0>((LAS char*)lds, cur, hn, nx, S); cur = nx; }
        } else if (ph == 3) {
            LAS bf16* Wt = (LAS bf16*)lds;
            LAS bf16* Vt = (LAS bf16*)(lds + 34816);
            LAS float* stat = (LAS float*)(lds + 69632);
            const float* ln_g = args.in[6]; const float* ln_b = args.in[7]; const float* sw = args.in[8]; const float* sb = args.in[9];
            for (int v = vcu; v < 2 * (M / 128); v += G) {
                const int u = v >> 1, half = v & 1;
                const int R0 = u * 128;
                {
                    const int row = tid >> 2, q = tid & 3; const GAS bf16* p = Z + (size_t)(R0 + row) * NIN0 + 1024 + q * 256; float s = 0.f, s2 = 0.f;
#pragma unroll 4
                    for (int j = 0; j < 32; ++j) { const v4u w = *(const GAS v4u*)(p + j * 8);
                        const float a0 = bflo(w.x), a1 = bfhi(w.x), a2 = bflo(w.y), a3 = bfhi(w.y), a4 = bflo(w.z), a5 = bfhi(w.z), a6 = bflo(w.w), a7 = bfhi(w.w);
                        s += ((a0 + a1) + (a2 + a3)) + ((a4 + a5) + (a6 + a7)); s2 += ((a0 * a0 + a1 * a1) + (a2 * a2 + a3 * a3)) + ((a4 * a4 + a5 * a5) + (a6 * a6 + a7 * a7)); }
                    s += __shfl_xor(s, 1); s += __shfl_xor(s, 2); s2 += __shfl_xor(s2, 1); s2 += __shfl_xor(s2, 2);
                    const float mu = s * (1.f / 1024.f), var = fmaxf(s2 * (1.f / 1024.f) - mu * mu, 0.f);
                    if (q == 0) { stat[row * 2] = mu; stat[row * 2 + 1] = 1.f / sqrtf(var + LN_EPS); }
                }
                __syncthreads();
                for (int gg = 0; gg < 4; ++gg) { const int g = half * 4 + gg;
                    {
                        const int i = tid >> 2, c0 = (tid & 3) * 32; const float* wp = sw + ((size_t)g * 128 + i) * 128 + c0;
#pragma unroll
                        for (int j = 0; j < 4; ++j) { const f32x4 a = *(const f32x4*)(wp + 8 * j), b = *(const f32x4*)(wp + 8 * j + 4); const int c = c0 + 8 * j;
                            v4u o; o.x = pk2(c + 0 <= i ? a.x : 0.f, c + 1 <= i ? a.y : 0.f); o.y = pk2(c + 2 <= i ? a.z : 0.f, c + 3 <= i ? a.w : 0.f);
                            o.z = pk2(c + 4 <= i ? b.x : 0.f, c + 5 <= i ? b.y : 0.f); o.w = pk2(c + 6 <= i ? b.z : 0.f, c + 7 <= i ? b.w : 0.f);
                            *(LAS v4u*)(Wt + i * 136 + c) = o; }
                    }
                    {
                        const int j = tid >> 2, d0 = (tid & 3) * 32; const GAS bf16* p = Z + (size_t)(R0 + j) * NIN0 + 1024 + g * 128 + d0;
                        const float mu = stat[j * 2], rs = stat[j * 2 + 1];
#pragma unroll
                        for (int c = 0; c < 4; ++c) { const v4u w = *(const GAS v4u*)(p + 8 * c); const unsigned ww[4] = {w.x, w.y, w.z, w.w};
#pragma unroll
                            for (int e = 0; e < 4; ++e) { const int d = d0 + 8 * c + 2 * e;
                                const float v0 = (bflo(ww[e]) - mu) * rs * ln_g[g * 128 + d] + ln_b[g * 128 + d], v1 = (bfhi(ww[e]) - mu) * rs * ln_g[g * 128 + d + 1] + ln_b[g * 128 + d + 1];
                                Vt[d * 136 + j] = (bf16)f2bf(v0); Vt[(d + 1) * 136 + j] = (bf16)f2bf(v1); } }
                    }
                    __syncthreads();
                    {
                        const int fr = lane & 15, fq = lane >> 4; f32x4 acc[8];
#pragma unroll
                        for (int nt = 0; nt < 8; ++nt) acc[nt] = (f32x4){0.f, 0.f, 0.f, 0.f};
#pragma unroll
                        for (int ks = 0; ks < 4; ++ks) { const bf16x8 a = *(const LAS bf16x8*)(Wt + (16 * wave + fr) * 136 + ks * 32 + fq * 8);
#pragma unroll
                            for (int nt = 0; nt < 8; ++nt) { const bf16x8 b = *(const LAS bf16x8*)(Vt + (nt * 16 + fr) * 136 + ks * 32 + fq * 8);
                                acc[nt] = __builtin_amdgcn_mfma_f32_16x16x32_bf16(b, a, acc[nt], 0, 0, 0); } }
                        const int i = 16 * wave + fr; const float bias = sb[g * 128 + i];
#pragma unroll
                        for (int nt = 0; nt < 8; ++nt) { const int d = nt * 16 + 4 * fq; const v2u uu = *(const GAS v2u*)(Z + (size_t)(R0 + i) * NIN0 + g * 128 + d);
                            v2u o; o.x = pk2(bflo(uu.x) * (acc[nt][0] + bias), bfhi(uu.x) * (acc[nt][1] + bias)); o.y = pk2(bflo(uu.y) * (acc[nt][2] + bias), bfhi(uu.y) * (acc[nt][3] + bias));
                            *(GAS v2u*)(CAT + (size_t)(R0 + i) * DM + g * 128 + d) = o; }
                    }
                    __syncthreads();
                }
                {
                    const int row = R0 + (tid >> 2), q = tid & 3;
                    { const int h = half * 4 + q;
                        const float l0 = LSE[(size_t)row * 8 + h], l1 = LSE[(size_t)M * 8 + (size_t)row * 8 + h], l2 = LSE[(size_t)2 * M * 8 + (size_t)row * 8 + h];
                        const float mx = fmaxf(l0, fmaxf(l1, l2)); float w0 = exp2f(l0 - mx), w1 = exp2f(l1 - mx), w2 = exp2f(l2 - mx); const float inv = 1.f / (w0 + w1 + w2); w0 *= inv; w1 *= inv; w2 *= inv;
                        GAS bf16* c = CAT + (size_t)row * DM + 1024 + h * 128; const GAS bf16* o4 = OB4 + (size_t)row * 1024 + h * 128; const GAS bf16* o16 = OB16 + (size_t)row * 1024 + h * 128;
#pragma unroll 4
                        for (int d = 0; d < 128; d += 8) { const v4u a = *(const GAS v4u*)(c + d), b = *(const GAS v4u*)(o4 + d), e = *(const GAS v4u*)(o16 + d);
                            v4u o; o.x = pk2(w0 * bflo(a.x) + w1 * bflo(b.x) + w2 * bflo(e.x), w0 * bfhi(a.x) + w1 * bfhi(b.x) + w2 * bfhi(e.x));
                            o.y = pk2(w0 * bflo(a.y) + w1 * bflo(b.y) + w2 * bflo(e.y), w0 * bfhi(a.y) + w1 * bfhi(b.y) + w2 * bfhi(e.y));
                            o.z = pk2(w0 * bflo(a.z) + w1 * bflo(b.z) + w2 * bflo(e.z), w0 * bfhi(a.z) + w1 * bfhi(b.z) + w2 * bfhi(e.z));
                            o.w = pk2(w0 * bflo(a.w) + w1 * bflo(b.w) + w2 * bflo(e.w), w0 * bfhi(a.w) + w1 * bfhi(b.w) + w2 * bfhi(e.w));
                            *(GAS v4u*)(c + d) = o; } }
                }
                __syncthreads();
            }
        } else if (ph == 10) {
            auto mk = [&](int q) __attribute__((always_inline)) { att::UnitP u;
                const int it = (vq + G * (q >> 1)) % 512, bh = it / 8, xq = it % 8, b = bh / 16, h = bh % 16;
                u.Q = QKV + (size_t)(b * SEQ) * NQKV + h * 128; u.K = u.Q + 2048; u.V = u.Q + 4096; u.pitch = (size_t)NQKV;
                u.O = OBUF + (size_t)(b * SEQ) * DM + h * 128; u.opitch = (size_t)DM; u.lse = nullptr; u.lse_stride = 0; u.P0 = ((q & 1) ? xq : 15 - xq) * 256; u.slope2 = 0.f; return u; };
            const int nq = 2 * ((512 - vq + G - 1) / G);
            att::Seam S; att::UnitP cur = mk(0);
            att::attn_prefetch<1>(cur, S, tid);
            for (int q = 0; q < nq; ++q) { const bool hn = q + 1 < nq; const att::UnitP nx = hn ? mk(q + 1) : cur;
                att::attn_unit<1>((LAS char*)lds, cur, hn, nx, S); cur = nx; }
        } else {
            const float* gpost; const float* gnext;
            if (ph == 5)       { gpost = args.in[2];      gnext = args.in[3]; }
            else if (ph == 8)  { gpost = args.in[4];      gnext = args.in[1] + DM; }
            else if (ph == 12) { gpost = args.in[2] + DM; gnext = args.in[3] + DM; }
            else               { gpost = args.in[4] + DM; gnext = nullptr; }
            GAS bf16* XR = (GAS bf16*)(ws + WS_XR);
            if (ph == 8) {
                LAS float* scr = (LAS float*)(lds + wave * 16640);
                constexpr int I2 = (DM / 64) * (NQKV / 64), I3 = (DM / 64) * (DM / 64), I4 = (DM / 64) * (DFF / 64), I5 = (DFF / 64) * (DM / 64);
                constexpr int NITEMS = I2 + I3 + I4 + I5;
                for (int it = gw; it < NITEMS; it += NGW) {
                    int r = it;
                    if (r < I2) { p0_transpose_item(args.in[11], DM, NQKV, (GAS bf16*)(ws + WS_SBIN), scr, r, lane, args.in[1] + DM); continue; } r -= I2;
                    if (r < I3) { p0_transpose_item(args.in[12], DM, DM, (GAS bf16*)(ws + WS_SBOUT), scr, r, lane); continue; } r -= I3;
                    if (r < I4) { p0_transpose_item(args.in[13] + (size_t)DM * DFF, DM, DFF, (GAS bf16*)(ws + WS_W1_1), scr, r, lane, args.in[3] + DM); continue; } r -= I4;
                    p0_transpose_item(args.in[14] + (size_t)DM * DFF, DFF, DM, (GAS bf16*)(ws + WS_W2_1), scr, r, lane);
                }
            }
            for (int m = gw; m < M; m += NGW) {
                GAS bf16* yr = YH + (size_t)m * DM + lane * 8; GAS bf16* xr = XR + (size_t)m * DM + lane * 8;
                f32x4 v[8]; v4u yw[4]; float ssy = 0.f;
#pragma unroll
                for (int j = 0; j < 4; ++j) yw[j] = __builtin_nontemporal_load((const GAS v4u*)(yr + 512 * j));
#pragma unroll
                for (int j = 0; j < 4; ++j) { const v4u w = __builtin_nontemporal_load((const GAS v4u*)(xr + 512 * j));
                    v[2 * j] = (f32x4){bflo(w.x), bfhi(w.x), bflo(w.y), bfhi(w.y)}; v[2 * j + 1] = (f32x4){bflo(w.z), bfhi(w.z), bflo(w.w), bfhi(w.w)}; }
                f32x4 y[8];
#pragma unroll
                for (int j = 0; j < 4; ++j) { y[2 * j] = (f32x4){bflo(yw[j].x), bfhi(yw[j].x), bflo(yw[j].y), bfhi(yw[j].y)}; y[2 * j + 1] = (f32x4){bflo(yw[j].z), bfhi(yw[j].z), bflo(yw[j].w), bfhi(yw[j].w)}; }
#pragma unroll
                for (int j = 0; j < 8; ++j) ssy += (y[j].x * y[j].x + y[j].y * y[j].y) + (y[j].z * y[j].z + y[j].w * y[j].w);
                const float ry = 1.f / sqrtf(wave_sum(ssy) * (1.f / DM) + RMS_EPS);
                float ssx = 0.f;
#pragma unroll
                for (int j = 0; j < 8; ++j) { const f32x4 gp = *(const f32x4*)(gpost + lane * 8 + 512 * (j >> 1) + 4 * (j & 1)); v[j] = v[j] + y[j] * ry * gp;
                    ssx += (v[j].x * v[j].x + v[j].y * v[j].y) + (v[j].z * v[j].z + v[j].w * v[j].w); }
                if (gnext) {
#pragma unroll
                    for (int j = 0; j < 4; ++j) { v4u o; o.x = pk2(v[2 * j].x, v[2 * j].y); o.y = pk2(v[2 * j].z, v[2 * j].w); o.z = pk2(v[2 * j + 1].x, v[2 * j + 1].y); o.w = pk2(v[2 * j + 1].z, v[2 * j + 1].w);
                        *(GAS v4u*)(xr + 512 * j) = o; }
                    const float rx = 1.f / sqrtf(wave_sum(ssx) * (1.f / DM) + RMS_EPS);
                    if (lane == 0) ((GAS float*)(ws + WS_RX))[m] = rx;
                } else {
                    float* orow = out + (size_t)m * DM + lane * 8;
#pragma unroll
                    for (int j = 0; j < 8; ++j) __builtin_nontemporal_store(v[j], (f32x4*)(orow + 512 * (j >> 1) + 4 * (j & 1)));
                }
            }
        }
        if (PROBE_MASK) __syncthreads();
        }
        if (ph + 1 < args.ph_hi) {
            if (ph == args.ph_lo) { cooperative_groups::this_grid().sync(); xbar = xcd_barrier_post(barw, xst); }
            else xcd_barrier(xbar);
        }
    }
}

extern "C" void kernel_launch(void* const* d_in, const int* in_sizes, int n_in, void* d_out, int out_size, void* d_ws, size_t ws_size, hipStream_t stream) {
    static int grid = 0;
    if (grid == 0) {
        if (n_in != 15 || in_sizes[0] != M * DM || out_size != M * DM || ws_size < WS_END) { fprintf(stderr, "kernel_launch: unexpected shapes (n_in %d, in0 %d, out %d, ws %zu)\n", n_in, n_in > 0 ? in_sizes[0] : -1, out_size, ws_size); grid = -1; return; }
        int dev = 0, cus = 0, per_cu = 0;
        (void)hipGetDevice(&dev); (void)hipDeviceGetAttribute(&cus, hipDeviceAttributeMultiprocessorCount, dev);
        if (hipFuncSetAttribute((const void*)mk_fwd, hipFuncAttributeMaxDynamicSharedMemorySize, LDS_BYTES) != hipSuccess) { fprintf(stderr, "kernel_launch: hipFuncSetAttribute failed\n"); grid = -1; return; }
        if (hipOccupancyMaxActiveBlocksPerMultiprocessor(&per_cu, (const void*)mk_fwd, NWAVES * 64, LDS_BYTES) != hipSuccess || per_cu < 1) { fprintf(stderr, "kernel_launch: occupancy query says %d\n", per_cu); per_cu = 1; }
        (void)hipGetLastError();
        grid = cus > 0 ? cus : 256;
    }
    if (grid < 0) return;
    Args a{};
    for (int i = 0; i < 15; ++i) a.in[i] = (const float*)d_in[i];
    a.out = (float*)d_out; a.ws = (unsigned char*)d_ws;
#if MK_N_LAUNCHES == 1
    a.ph_lo = 0; a.ph_hi = N_PHASES;
    void* kargs[] = {&a};
    hipError_t e = hipLaunchCooperativeKernel((const void*)mk_fwd, dim3(grid), dim3(NWAVES * 64), kargs, LDS_BYTES, stream);
    if (e != hipSuccess) fprintf(stderr, "kernel_launch: cooperative launch failed: %s (grid %d)\n", hipGetErrorString(e), grid);
#else
    for (int p = 0; p < N_PHASES; ++p) { a.ph_lo = p; a.ph_hi = p + 1; hipLaunchKernelGGL(mk_fwd, dim3(grid), dim3(NWAVES * 64), LDS_BYTES, stream, a); }
#endif
}
```

```cpp
#include <hip/hip_runtime.h>
#include <hip/hip_cooperative_groups.h>
#include <cstdio>
#include <cstdint>
#define GAS __attribute__((address_space(1)))
__device__ __forceinline__ int opaque_tid() { int t = (int)threadIdx.x; asm volatile("" : "+v"(t)); return t; }
namespace pg8 {
#define PG8_LAS __attribute__((address_space(3)))
typedef unsigned short bf16_t;
typedef short bf16x8 __attribute__((ext_vector_type(8)));
typedef float f32x4 __attribute__((ext_vector_type(4)));
typedef unsigned u32x4 __attribute__((ext_vector_type(4)));
constexpr int BM = 256, BK = 64, HALF = 128, HTB = HALF * BK * 2  , STAGE_BYTES = 8 * HTB, NXCD = 8, WGM = 4;

__host__ __device__ __forceinline__ int lds_byte(int r, int c) { const int st = (r >> 4) * 2 + (c >> 5), rr = r & 15, cc = c & 31, ob = rr * 64 + cc * 2; return st * 1024 + (ob ^ (((ob >> 9) & 1) << 5)); }
__host__ __device__ __forceinline__ void stage_rc(int b, int& R, int& C) { const int st = b / 1024, sb = b % 1024, swz = sb ^ (((sb >> 9) & 1) << 5); R = (st >> 1) * 16 + swz / 64; C = (st & 1) * 32 + (swz % 64) / 2; }
__host__ __device__ __forceinline__ int perm32(int rho) { const int n = rho >> 4, i = rho & 15; return 8 * (i >> 2) + 4 * n + (i & 3); }

struct Unit { int pm, pn; };
struct Gemm { const GAS bf16_t* A; const GAS bf16_t* Bt; int M, N, K; };

struct StaticOrder {
    int nM, nN, nwg, G, c, wgm, rev;
    __host__ __device__ void init(int M, int N, int G_, int c_, int wgm_ = WGM, int rev_ = 0) { nM = M / BM; nN = N / BM; nwg = nM * nN; G = G_; c = c_; wgm = wgm_; rev = rev_; }
    __host__ __device__ bool next(int i, Unit& u) const {
        const long L = (long)i * G + c; if (L >= nwg) return false;
        int wgid = (int)L; { const int q = nwg / NXCD, r = nwg % NXCD, xcd = wgid % NXCD; int off = wgid / NXCD; if (rev) off = (xcd < r ? q : q - 1) - off;
            wgid = (xcd < r ? xcd * (q + 1) : r * (q + 1) + (xcd - r) * q) + off; }
        const int nig = wgm * nN, gid = wgid / nig, fm = gid * wgm, gsz = (nM - fm) < wgm ? (nM - fm) : wgm;
        u.pm = fm + ((wgid % nig) % gsz); u.pn = (wgid % nig) / gsz; return true;
    }
    __device__ __forceinline__ void a_ready(const Unit&) const {}
    __device__ __forceinline__ void done(const Unit&) const {}
};

__device__ __forceinline__ unsigned cvt_pk_bf16(float lo, float hi) { unsigned r; asm volatile("v_cvt_pk_bf16_f32 %0, %1, %2" : "=v"(r) : "v"(lo), "v"(hi)); return r; }
typedef float f32x2 __attribute__((ext_vector_type(2)));
__device__ __forceinline__ f32x2 gelu_pk(f32x2 v) {
    const f32x2 av = __builtin_elementwise_abs(v), d = av * 0.2316418882f + 1.0f;
    f32x2 t; t.x = __builtin_amdgcn_rcpf(d.x); t.y = __builtin_amdgcn_rcpf(d.y);
    f32x2 q = t * 0.5307027145f + (-0.7265760135f); q = q * t + 0.7107068705f; q = q * t + (-0.142248368f); q = q * t + 0.127414796f; q = q * t;
    const f32x2 s = (v * v) * (-0.72134752044f);
    f32x2 e; e.x = __builtin_amdgcn_exp2f(s.x); e.y = __builtin_amdgcn_exp2f(s.y);
    const f32x2 m = v * (q * e), r = v - m;
    f32x2 o; o.x = v.x < 0.f ? m.x : r.x; o.y = v.y < 0.f ? m.y : r.y; return o;
}

struct EpiGen {
    static constexpr bool PERM = true, AFTER_DRAIN = false;
    GAS bf16_t* O; int ldc; int gelu_tiles; int sc_lo, sc_hi; float sc; int relu2; const GAS float* rs;
    __device__ __forceinline__ void pre(const Unit& u, PG8_LAS unsigned char* lds, int wid, int wr, int lane, int ui) const {
        if (rs) {
#pragma unroll
            for (int ai = 0; ai < 2; ++ai)
                __builtin_amdgcn_global_load_lds((const GAS unsigned*)(rs + (size_t)u.pm * BM + ai * HALF + wr * 64 + lane), (PG8_LAS unsigned*)(lds + 131072 + (ui & 1) * 4096 + wid * 512 + ai * 256), 4, 0, 0);
        }
    }
    __device__ __forceinline__ void operator()(const f32x4 (&acc)[2][2][4][2], const Unit& u, int wr, int wc, int fr, int fq, PG8_LAS unsigned char* lds, int wid, int ui) const {
        const PG8_LAS float* rsl = (const PG8_LAS float*)(lds + 131072 + (ui & 1) * 4096 + wid * 512);
        const int row0 = u.pm * BM + wr * 64 + fr, col0 = u.pn * BM + wc * 32 + 8 * fq;
        const bool do_gelu = u.pn < gelu_tiles;
        const float s = (u.pn >= sc_lo && u.pn < sc_hi) ? sc : 1.f;
#pragma unroll
        for (int ai = 0; ai < 2; ++ai)
#pragma unroll
            for (int m = 0; m < 4; ++m) { GAS bf16_t* rowp = O + (size_t)(row0 + ai * HALF + m * 16) * ldc + col0; const float rsc = rs ? rsl[ai * 64 + m * 16 + fr] : 1.f;
#pragma unroll
                for (int bj = 0; bj < 2; ++bj) { f32x4 v0 = acc[ai][bj][m][0] * rsc, v1 = acc[ai][bj][m][1] * rsc;
                    if (do_gelu) { f32x2 a = gelu_pk((f32x2){v0[0], v0[1]}), b = gelu_pk((f32x2){v0[2], v0[3]}), c = gelu_pk((f32x2){v1[0], v1[1]}), d = gelu_pk((f32x2){v1[2], v1[3]});
                        v0 = (f32x4){a.x, a.y, b.x, b.y}; v1 = (f32x4){c.x, c.y, d.x, d.y}; }
                    if (relu2) {
#pragma unroll
                        for (int j = 0; j < 4; ++j) { const float t0 = fmaxf(v0[j], 0.f), t1 = fmaxf(v1[j], 0.f); v0[j] = t0 * t0; v1[j] = t1 * t1; } }
                    v0 = v0 * s; v1 = v1 * s;
                    u32x4 w; w.x = cvt_pk_bf16(v0[0], v0[1]); w.y = cvt_pk_bf16(v0[2], v0[3]); w.z = cvt_pk_bf16(v1[0], v1[1]); w.w = cvt_pk_bf16(v1[2], v1[3]);
                    #ifdef EPI_NT
                    __builtin_nontemporal_store(w, (GAS u32x4*)(rowp + bj * HALF)); } }
#else
                    *(GAS u32x4*)(rowp + bj * HALF) = w; } }
#endif
    }
};

template <class Epi, class Sched, bool ALIGN_EPI = false, bool SP2 = false>
__device__ __forceinline__ void gemm_phase(PG8_LAS unsigned char* lds, const Gemm g, const Sched& S, const Epi& E) {
    const int tid = opaque_tid(), wid = __builtin_amdgcn_readfirstlane(tid >> 6), lane = tid & 63, wr = wid >> 2, wc = wid & 3, fr = lane & 15, fq = lane >> 4;
    const int K = g.K, nt = K / BK;
    unsigned voffA[2], voffB[2];
#pragma unroll
    for (int i = 0; i < 2; ++i) { int R, C; stage_rc(tid * 16 + i * 8192, R, C); const int Rb = Epi::PERM ? ((R & ~31) + perm32(R & 31)) : R;
        voffA[i] = (unsigned)(R * K + C) * 2u; voffB[i] = (unsigned)(Rb * K + C) * 2u; }
    const size_t kstep = (size_t)(BK * 2);
    const size_t hstep = (size_t)HALF * K * 2;
    const size_t tstep = 2 * hstep;
    const unsigned ldsw = (unsigned)wid * 1024u;
    const int aoff = lds_byte(wr * 64 + fr, fq * 8), boff = lds_byte(wc * 32 + fr, fq * 8);
#ifndef PG8_PFD
#define PG8_PFD 0
#endif
    const int pfi = tid;
    const bool pfB = (pfi >> 8) != 0;
    const unsigned pfoff = (unsigned)(((pfi >> 7) & 1) * (HALF * K * 2) + (pfi & 127) * (K * 2));
#define PG8_PF(kt) do { if (PG8_PFD) { int kt_ = (kt); const GAS char* pa_ = cA; const GAS char* pb_ = cB; if (kt_ >= nt) { kt_ -= nt; pa_ = nA; pb_ = nB; } \
        const GAS char* p_ = (pfB ? pb_ : pa_) + pfoff + (size_t)kt_ * kstep; \
        __builtin_amdgcn_global_load_lds((const GAS unsigned*)p_, (PG8_LAS unsigned*)(lds + 131072 + wid * 256), 4, 0, 0); } } while (0)
#define PG8_WAIT_VL() do { if (PG8_PFD) PG8_WAIT_V(9); else PG8_WAIT_V(8); } while (0)
#define PG8_SA(b, h) (((b) * 2 + (h)) * HTB)
#define PG8_SB(b, h) ((4 + (b) * 2 + (h)) * HTB)
#ifndef PG8_AUX_A
#define PG8_AUX_A 0
#endif
#ifndef PG8_AUX_B
#define PG8_AUX_B 0
#endif
#define PG8_STAGE(bufoff, gbase, voff) do { _Pragma("unroll") for (int _i = 0; _i < 2; ++_i) { \
        if ((bufoff) < 4 * HTB) __builtin_amdgcn_global_load_lds((const GAS unsigned*)((const GAS char*)(gbase) + (voff)[_i]), (PG8_LAS unsigned*)(lds + (bufoff) + ldsw + _i * 8192), 16, 0, PG8_AUX_A); \
        else __builtin_amdgcn_global_load_lds((const GAS unsigned*)((const GAS char*)(gbase) + (voff)[_i]), (PG8_LAS unsigned*)(lds + (bufoff) + ldsw + _i * 8192), 16, 0, PG8_AUX_B); } } while (0)
#define PG8_LDA(dst, b, h) do { _Pragma("unroll") for (int m = 0; m < 4; ++m) _Pragma("unroll") for (int k = 0; k < 2; ++k) dst[m][k] = *(const PG8_LAS bf16x8*)(lds + PG8_SA(b, h) + aoff + m * 2048 + k * 1024); } while (0)
#define PG8_LDB(dst, b, h) do { _Pragma("unroll") for (int n = 0; n < 2; ++n) _Pragma("unroll") for (int k = 0; k < 2; ++k) dst[n][k] = *(const PG8_LAS bf16x8*)(lds + PG8_SB(b, h) + boff + n * 2048 + k * 1024); } while (0)
#define PG8_MMA(ai, bj, At, Bt) do { __builtin_amdgcn_s_setprio(1); _Pragma("unroll") for (int m = 0; m < 4; ++m) _Pragma("unroll") for (int n = 0; n < 2; ++n) _Pragma("unroll") for (int k = 0; k < 2; ++k) \
        acc[ai][bj][m][n] = __builtin_amdgcn_mfma_f32_16x16x32_bf16(Bt[n][k], At[m][k], acc[ai][bj][m][n], 0, 0, 0); __builtin_amdgcn_s_setprio(0); } while (0)
#define PG8_WAIT_V(n) asm volatile("s_waitcnt vmcnt(" #n ")" ::: "memory")
#define PG8_WAIT_L(n) asm volatile("s_waitcnt lgkmcnt(" #n ")" ::: "memory")
#define PG8_BAR __builtin_amdgcn_s_barrier()
#define PG8_SCHED __builtin_amdgcn_sched_barrier(0)
    Unit cur, nxt; int ui = 0;
    if (!S.next(0, cur)) return;
    f32x4 acc[2][2][4][2];
#pragma unroll
    for (int a = 0; a < 2; ++a)
#pragma unroll
        for (int b = 0; b < 2; ++b)
#pragma unroll
            for (int m = 0; m < 4; ++m)
#pragma unroll
                for (int n = 0; n < 2; ++n) acc[a][b][m][n] = (f32x4){0.f, 0.f, 0.f, 0.f};
    bf16x8 At[4][2], B0[2][2], B1[2][2];
    const GAS char* cA = (const GAS char*)g.A + (size_t)cur.pm * tstep; const GAS char* cB = (const GAS char*)g.Bt + (size_t)cur.pn * tstep;
    S.a_ready(cur);
    if constexpr (SP2) {
        PG8_STAGE(PG8_SB(0, 0), cB, voffB); PG8_STAGE(PG8_SB(0, 1), cB + hstep, voffB); PG8_STAGE(PG8_SA(0, 0), cA, voffA); PG8_STAGE(PG8_SA(0, 1), cA + hstep, voffA);
        if (wr == 1) PG8_BAR;
        PG8_WAIT_V(2); PG8_BAR;
        PG8_STAGE(PG8_SB(1, 0), cB + kstep, voffB); PG8_STAGE(PG8_SA(1, 0), cA + kstep, voffA); PG8_STAGE(PG8_SB(1, 1), cB + hstep + kstep, voffB);
        PG8_WAIT_V(6); PG8_BAR;
    } else {
        PG8_STAGE(PG8_SB(0, 0), cB, voffB); PG8_STAGE(PG8_SA(0, 0), cA, voffA); PG8_STAGE(PG8_SB(0, 1), cB + hstep, voffB); PG8_STAGE(PG8_SA(0, 1), cA + hstep, voffA);
        if (wr == 1) PG8_BAR;
        PG8_WAIT_V(4); PG8_BAR;
        PG8_STAGE(PG8_SB(1, 0), cB + kstep, voffB); PG8_STAGE(PG8_SA(1, 0), cA + kstep, voffA); PG8_STAGE(PG8_SB(1, 1), cB + hstep + kstep, voffB);
        PG8_WAIT_V(6); PG8_BAR;
    }
    for (;;) {
        const bool has_next = S.next(ui + 1, nxt);
        E.pre(cur, lds, wid, wr, lane, ui);
        const GAS char* nA = has_next ? (const GAS char*)g.A + (size_t)nxt.pm * tstep : cA; const GAS char* nB = has_next ? (const GAS char*)g.Bt + (size_t)nxt.pn * tstep : cB;
        for (int t = 0; t < nt; t += 2) {
            const bool last = (t == nt - 2);
            const GAS char* a1 = cA + (size_t)(t + 1) * kstep;
            const GAS char* a2 = last ? nA : cA + (size_t)(t + 2) * kstep; const GAS char* b2 = last ? nB : cB + (size_t)(t + 2) * kstep;
            const GAS char* a3 = a2 + kstep; const GAS char* b3 = b2 + kstep;
            if (last && has_next) S.a_ready(nxt);
            if constexpr (SP2) {
            PG8_LDB(B0, 0, 0); PG8_LDB(B1, 0, 1); PG8_SCHED; PG8_LDA(At, 0, 0); PG8_STAGE(PG8_SA(1, 1), a1 + hstep, voffA);
            PG8_WAIT_VL(); PG8_WAIT_L(0); PG8_BAR; PG8_MMA(0, 0, At, B0); PG8_MMA(0, 1, At, B1); PG8_BAR; PG8_SCHED;
            PG8_LDA(At, 0, 1); PG8_STAGE(PG8_SB(0, 0), b2, voffB); PG8_STAGE(PG8_SB(0, 1), b2 + hstep, voffB); PG8_STAGE(PG8_SA(0, 0), a2, voffA); PG8_PF(t + PG8_PFD);
            PG8_WAIT_VL(); PG8_WAIT_L(0); PG8_BAR; PG8_MMA(1, 0, At, B0); PG8_MMA(1, 1, At, B1); PG8_BAR; PG8_SCHED;
            PG8_LDB(B0, 1, 0); PG8_LDB(B1, 1, 1); PG8_SCHED; PG8_LDA(At, 1, 0); PG8_STAGE(PG8_SA(0, 1), a2 + hstep, voffA);
            PG8_WAIT_VL(); PG8_WAIT_L(0); PG8_BAR; PG8_MMA(0, 0, At, B0); PG8_MMA(0, 1, At, B1); PG8_BAR; PG8_SCHED;
            PG8_LDA(At, 1, 1); PG8_STAGE(PG8_SB(1, 0), b3, voffB); PG8_STAGE(PG8_SB(1, 1), b3 + hstep, voffB); PG8_STAGE(PG8_SA(1, 0), a3, voffA); PG8_PF(t + 1 + PG8_PFD);
            PG8_WAIT_VL(); PG8_WAIT_L(0); PG8_BAR; PG8_MMA(1, 0, At, B0); PG8_MMA(1, 1, At, B1); PG8_BAR; PG8_SCHED;
            } else {
            PG8_LDB(B0, 0, 0); PG8_SCHED; PG8_LDA(At, 0, 0); PG8_STAGE(PG8_SA(1, 1), a1 + hstep, voffA);
            PG8_WAIT_L(8); PG8_BAR; PG8_WAIT_L(0); PG8_MMA(0, 0, At, B0); PG8_BAR; PG8_SCHED;
            PG8_LDB(B1, 0, 1); PG8_STAGE(PG8_SB(0, 0), b2, voffB);
            PG8_BAR; PG8_WAIT_L(0); PG8_MMA(0, 1, At, B1); PG8_BAR;
            PG8_LDA(At, 0, 1); PG8_STAGE(PG8_SA(0, 0), a2, voffA);
            PG8_BAR; PG8_WAIT_L(0); PG8_MMA(1, 0, At, B0); PG8_BAR; PG8_SCHED;
            PG8_STAGE(PG8_SB(0, 1), b2 + hstep, voffB);
            PG8_WAIT_V(6); PG8_BAR; PG8_MMA(1, 1, At, B1); PG8_BAR;
            PG8_LDB(B0, 1, 0); PG8_SCHED; PG8_LDA(At, 1, 0); PG8_STAGE(PG8_SA(0, 1), a2 + hstep, voffA);
            PG8_WAIT_L(8); PG8_BAR; PG8_WAIT_L(0); PG8_MMA(0, 0, At, B0); PG8_BAR; PG8_SCHED;
            PG8_LDB(B1, 1, 1); PG8_STAGE(PG8_SB(1, 0), b3, voffB);
            PG8_BAR; PG8_WAIT_L(0); PG8_MMA(0, 1, At, B1); PG8_BAR;
            PG8_LDA(At, 1, 1); PG8_STAGE(PG8_SA(1, 0), a3, voffA);
            PG8_BAR; PG8_WAIT_L(0); PG8_MMA(1, 0, At, B0); PG8_BAR; PG8_SCHED;
            PG8_STAGE(PG8_SB(1, 1), b3 + hstep, voffB);
            PG8_WAIT_V(6); PG8_BAR; PG8_MMA(1, 1, At, B1); PG8_BAR;
            }
        }
        if constexpr (ALIGN_EPI) { if (wr == 0) PG8_BAR; }
        if constexpr (!Epi::AFTER_DRAIN) { E(acc, cur, wr, wc, fr, fq, lds, wid, ui);
#ifdef PROBE_EPI
            asm volatile("" ::: "memory"); E(acc, cur, wr, wc, fr, fq, lds, wid, ui);
#endif
            S.done(cur); }
        if (!has_next) break;
#pragma unroll
        for (int a = 0; a < 2; ++a)
#pragma unroll
            for (int b = 0; b < 2; ++b)
#pragma unroll
                for (int m = 0; m < 4; ++m)
#pragma unroll
                    for (int n = 0; n < 2; ++n) acc[a][b][m][n] = (f32x4){0.f, 0.f, 0.f, 0.f};
        cur = nxt; cA = nA; cB = nB; ++ui;
        if constexpr (ALIGN_EPI) { if (wr == 1) PG8_BAR; }
    }
    PG8_WAIT_V(0);
    if constexpr (!ALIGN_EPI) { if (wr == 0) PG8_BAR; }
    PG8_BAR;
    if constexpr (Epi::AFTER_DRAIN) { E.fused(acc, cur, wr, wc, fr, fq, lds, wid, lane); S.done(cur); }
#undef PG8_SA
#undef PG8_SB
#undef PG8_STAGE
#undef PG8_LDA
#undef PG8_LDB
#undef PG8_MMA
#undef PG8_WAIT_V
#undef PG8_WAIT_L
#undef PG8_BAR
#undef PG8_SCHED
#undef PG8_PF
#undef PG8_WAIT_VL
}
}

namespace att {
#define ALAS __attribute__((address_space(3)))
typedef unsigned short bf16;
typedef short bf16x8 __attribute__((ext_vector_type(8)));
typedef short s16x4 __attribute__((ext_vector_type(4)));
typedef float f32x16 __attribute__((ext_vector_type(16)));
typedef float f32x4 __attribute__((ext_vector_type(4)));
typedef unsigned u32x4 __attribute__((ext_vector_type(4)));
constexpr int SHM_V = 16384, SHM_K = 16384;
#define KSWZ(row, colB) ((row) * 256 + ((colB) ^ (((row) & 7) << 4)))
#define SBAR() __builtin_amdgcn_sched_barrier(0)
__device__ __forceinline__ int v_st(int k, int c) { const int kk = (k & ~0xC) | ((k & 4) << 1) | ((k & 8) >> 1); return ((kk >> 3) * 4 + (c >> 5)) * 512 + ((kk & 7) * 32 + (c & 31)) * 2; }
__device__ __forceinline__ int v_rd_base(int lane) { return ((lane & 3) << 3) | (((lane >> 2) & 3) << 6) | (((lane >> 4) & 1) << 5) | (((lane >> 5) & 1) << 8); }
__device__ __forceinline__ int crow(int r, int hi) { return (r & 3) + 8 * (r >> 2) + 4 * hi; }
__device__ __forceinline__ unsigned cvtpk(float lo, float hi) { unsigned r; asm volatile("v_cvt_pk_bf16_f32 %0, %1, %2" : "=v"(r) : "v"(lo), "v"(hi)); return r; }

__device__ __forceinline__ void qkt(f32x16& p0, f32x16& p1, const ALAS char* Kb, int r32, int hi, const bf16x8* qr) {
    p0 = f32x16{}; p1 = f32x16{};
    const ALAS char* kb[4];
#pragma unroll
    for (int dd = 0; dd < 4; ++dd) kb[dd] = Kb + KSWZ(r32, (dd * 16 + hi * 8) * 2);
#ifdef ATT_PRIO
    __builtin_amdgcn_s_setprio(1);
#endif
#pragma unroll
    for (int d0 = 0; d0 < 8; ++d0) { const ALAS char* a = kb[d0 & 3] + (d0 >> 2) * 128;
        bf16x8 b0 = *reinterpret_cast<const ALAS bf16x8*>(a);
        bf16x8 b1 = *reinterpret_cast<const ALAS bf16x8*>(a + 32 * 256);
        p0 = __builtin_amdgcn_mfma_f32_32x32x16_bf16(b0, qr[d0], p0, 0, 0, 0);
        p1 = __builtin_amdgcn_mfma_f32_32x32x16_bf16(b1, qr[d0], p1, 0, 0, 0); }
#ifdef ATT_PRIO
    __builtin_amdgcn_s_setprio(0);
#endif
}
__device__ __forceinline__ void pv_tile(f32x16* o, int vb, bf16x8 pa0, bf16x8 pa1, bf16x8 pa2, bf16x8 pa3) {
#define TRRD(dst, off) asm volatile("ds_read_b64_tr_b16 %0, %1 offset:%2" : "=&v"(dst) : "v"(vb), "i"(off) : "memory")
#define PV_D0(d0) do { s16x4 l0, l1, l2, l3, h0, h1, h2, h3; constexpr int b_ = (d0) * 512; \
        TRRD(l0, b_); TRRD(h0, b_ + 2048); TRRD(l1, b_ + 4096); TRRD(h1, b_ + 6144); TRRD(l2, b_ + 8192); TRRD(h2, b_ + 10240); TRRD(l3, b_ + 12288); TRRD(h3, b_ + 14336); \
        asm volatile("s_waitcnt lgkmcnt(0)" ::: "memory"); SBAR(); \
        o[d0] = __builtin_amdgcn_mfma_f32_32x32x16_bf16(pa0, (bf16x8){l0[0], l0[1], l0[2], l0[3], h0[0], h0[1], h0[2], h0[3]}, o[d0], 0, 0, 0); \
        o[d0] = __builtin_amdgcn_mfma_f32_32x32x16_bf16(pa1, (bf16x8){l1[0], l1[1], l1[2], l1[3], h1[0], h1[1], h1[2], h1[3]}, o[d0], 0, 0, 0); \
        o[d0] = __builtin_amdgcn_mfma_f32_32x32x16_bf16(pa2, (bf16x8){l2[0], l2[1], l2[2], l2[3], h2[0], h2[1], h2[2], h2[3]}, o[d0], 0, 0, 0); \
        o[d0] = __builtin_amdgcn_mfma_f32_32x32x16_bf16(pa3, (bf16x8){l3[0], l3[1], l3[2], l3[3], h3[0], h3[1], h3[2], h3[3]}, o[d0], 0, 0, 0); } while (0)
#ifdef ATT_PRIO
    __builtin_amdgcn_s_setprio(1);
#endif
    PV_D0(0); PV_D0(1); PV_D0(2); PV_D0(3);
#ifdef ATT_PRIO
    __builtin_amdgcn_s_setprio(0);
#endif
#undef PV_D0
#undef TRRD
}
__device__ __forceinline__ float swap_sum(float x) { auto rr = __builtin_amdgcn_permlane32_swap(__float_as_uint(x), __float_as_uint(x), false, false); return __uint_as_float(rr[0]) + __uint_as_float(rr[1]); }
__device__ __forceinline__ float swap_max(float x) { auto rr = __builtin_amdgcn_permlane32_swap(__float_as_uint(x), __float_as_uint(x), false, false); return fmaxf(__uint_as_float(rr[0]), __uint_as_float(rr[1])); }
#define PK4(P, B_, OUT) do { unsigned a0 = cvtpk(P[B_+0], P[B_+1]), a1 = cvtpk(P[B_+2], P[B_+3]); \
        unsigned b0 = cvtpk(P[B_+4], P[B_+5]), b1 = cvtpk(P[B_+6], P[B_+7]); \
        auto r0 = __builtin_amdgcn_permlane32_swap(a0, b0, false, false); auto r1 = __builtin_amdgcn_permlane32_swap(a1, b1, false, false); \
        u32x4 w = {r0[0], r1[0], r0[1], r1[1]}; OUT = *reinterpret_cast<bf16x8*>(&w); } while (0)

template <int MODE>
__device__ __forceinline__ void attn_unit(ALAS char* lds, const GAS bf16* Qp, const GAS bf16* Kp, const GAS bf16* Vp, size_t pitch,
                                          GAS bf16* Op, size_t opitch, GAS float* lsep, int lse_stride, int P0, float slope2) {
    const int tid = opaque_tid(), wid = __builtin_amdgcn_readfirstlane(tid >> 6), lane = tid & 63, r32 = lane & 31, hi = lane >> 5;
    const int qlo = P0 + 32 * wid, qpos = qlo + r32;
    ALAS char* V_lds = lds; ALAS char* K_lds = lds + 2 * SHM_V;
    ALAS float* wsf = (ALAS float*)(lds + 2 * SHM_V + 2 * SHM_K) + wid * 64; ALAS float* li_l = wsf; ALAS float* al_l = wsf + 32;
    const int sr = tid >> 4, sc = (tid & 15) * 8, vst0 = v_st(sr, sc), vst1 = v_st(32 + sr, sc), kws = KSWZ(sr, sc * 2);
    const int vb0 = (int)(unsigned)(size_t)V_lds + v_rd_base(lane);
    int NT, tbase, tstep;
    if (MODE == 0) { const int lowk = P0 - 128; const int jlo = lowk > 0 ? lowk / 64 : 0; const int jhi = (P0 + 255) / 64; NT = jhi - jlo + 1; tbase = jlo; tstep = 1; }
    else { const int jhi = (P0 + 254) / 64; NT = jhi + 1; tbase = jhi; tstep = -1; }
    bf16x8 qr[8];
#pragma unroll
    for (int d0 = 0; d0 < 8; ++d0) qr[d0] = *(const GAS bf16x8*)(Qp + (size_t)qpos * pitch + d0 * 16 + hi * 8);
    bf16x8 sa0, sa1, sa2, sa3, sb0, sb1, sb2, sb3;
#define SLOAD(S, kb_) do { const GAS bf16* k_ = Kp + (size_t)((kb_) + sr) * pitch + sc; const GAS bf16* v_ = Vp + (size_t)((kb_) + sr) * pitch + sc; \
        S##0 = *(const GAS bf16x8*)k_; S##1 = *(const GAS bf16x8*)(k_ + 32 * pitch); S##2 = *(const GAS bf16x8*)v_; S##3 = *(const GAS bf16x8*)(v_ + 32 * pitch); } while (0)
#define SWRITE(S, bf_) do { *(ALAS bf16x8*)(K_lds + (bf_) * SHM_K + kws) = S##0; *(ALAS bf16x8*)(K_lds + (bf_) * SHM_K + kws + 32 * 256) = S##1; \
        *(ALAS bf16x8*)(V_lds + (bf_) * SHM_V + vst0) = S##2; *(ALAS bf16x8*)(V_lds + (bf_) * SHM_V + vst1) = S##3; } while (0)
#define TILE(i_) ((tbase + tstep * (i_)) * 64)
#ifndef DEEP_MASK
#define DEEP_MASK 0
#endif
    constexpr bool DEEP = ((DEEP_MASK >> MODE) & 1) != 0;
    SLOAD(sa, TILE(0)); if (DEEP && NT > 1) SLOAD(sb, TILE(1));
    SWRITE(sa, 0);
    __syncthreads();
#if defined(ATT_PROBE) && ATT_PROBE == 5
    asm volatile("" ::: "memory");
#pragma unroll
    for (int d0 = 0; d0 < 8; ++d0) { qr[d0] = *(const GAS bf16x8*)(Qp + (size_t)qpos * pitch + d0 * 16 + hi * 8); asm volatile("" : "+v"(qr[d0])); }
    SLOAD(sa, TILE(0)); asm volatile("s_waitcnt vmcnt(0)" ::: "memory"); SWRITE(sa, 0);
    __syncthreads();
#endif
    f32x16 o[4] = {};
    float m_reg = -1e30f, l_reg = 0.f, carry = 1.f;
    ALAS int* flg = (ALAS int*)(lds + 2 * SHM_V + 2 * SHM_K + 2048);
    bool alive = true;
    auto step = [&](const int i, const int buf) __attribute__((always_inline)) {
        const int kb = TILE(i);
        alive = (MODE == 0) ? true : (__any(carry != 0.f) != 0);
        const bool act = (MODE == 0) ? (kb <= qlo + 31 && kb + 63 >= qlo - 128) : (kb < qlo + 31 && alive);
        if (act) {
            f32x16 p0, p1; bf16x8 pa0, pa1, pa2, pa3;
            qkt(p0, p1, K_lds + buf * SHM_K, r32, hi, qr);
#if defined(ATT_PROBE) && ATT_PROBE == 1
            asm volatile("" : "+v"(p0), "+v"(p1)); qkt(p0, p1, K_lds + buf * SHM_K, r32, hi, qr);
#endif
            const int dqb = qpos - kb - 4 * hi;
            if (MODE == 0) {
                const float NEG = -__builtin_inff();
#pragma unroll
                for (int r = 0; r < 16; ++r) { const int c = (r & 3) + 8 * (r >> 2); const int d0_ = dqb - c, d1_ = d0_ - 32;
                    p0[r] = ((unsigned)d0_ <= 128u) ? fmaf(-slope2, (float)d0_, p0[r]) : NEG;
                    p1[r] = ((unsigned)d1_ <= 128u) ? fmaf(-slope2, (float)d1_, p1[r]) : NEG; }
                float pmax = p0[0];
#pragma unroll
                for (int r = 1; r < 16; ++r) pmax = fmaxf(pmax, p0[r]);
#pragma unroll
                for (int r = 0; r < 16; ++r) pmax = fmaxf(pmax, p1[r]);
                pmax = swap_max(pmax);
                float mn, alpha;
                if (__all(pmax - m_reg <= 8.f)) { mn = m_reg; alpha = 1.f; } else { mn = fmaxf(m_reg, pmax); alpha = __builtin_amdgcn_exp2f(m_reg - mn); m_reg = mn; }
                float ps = 0.f;
#pragma unroll
                for (int r = 0; r < 16; ++r) { p0[r] = __builtin_amdgcn_exp2f(p0[r] - mn); ps += p0[r]; }
#pragma unroll
                for (int r = 0; r < 16; ++r) { p1[r] = __builtin_amdgcn_exp2f(p1[r] - mn); ps += p1[r]; }
                ps = swap_sum(ps);
                l_reg = l_reg * alpha + ps;
                if (__any(alpha < 1.f)) { if (hi == 0) al_l[r32] = alpha; asm volatile("s_waitcnt lgkmcnt(0)" ::: "memory");
#pragma unroll
                    for (int d_ = 0; d_ < 4; ++d_)
#pragma unroll
                        for (int r = 0; r < 16; ++r) o[d_][r] *= al_l[crow(r, hi)]; }
            } else {
                const bool need_mask = kb + 63 >= qlo;
                f32x16 U0, U1;
#pragma unroll
                for (int r = 0; r < 16; ++r) { U0[r] = __builtin_amdgcn_rcpf(1.f + __builtin_amdgcn_exp2f(p0[r])); U1[r] = __builtin_amdgcn_rcpf(1.f + __builtin_amdgcn_exp2f(p1[r])); }
                if (need_mask) {
#pragma unroll
                    for (int r = 0; r < 16; ++r) { const int c = (r & 3) + 8 * (r >> 2); if (dqb - c <= 0) U0[r] = 1.f; if (dqb - c - 32 <= 0) U1[r] = 1.f; } }
#pragma unroll
                for (int r = 0; r < 16; ++r) { p0[r] = 1.f - U0[r]; p1[r] = 1.f - U1[r]; }
                float T[8], part[8];
#pragma unroll
                for (int G = 0; G < 8; ++G) { const int b = 4 * (G & 3); float g;
                    if (G < 4) { const float t2 = U0[b + 3], t1 = t2 * U0[b + 2], t0 = t1 * U0[b + 1]; g = t0 * U0[b]; U0[b + 2] = t2; U0[b + 1] = t1; U0[b] = t0; }
                    else       { const float t2 = U1[b + 3], t1 = t2 * U1[b + 2], t0 = t1 * U1[b + 1]; g = t0 * U1[b]; U1[b + 2] = t2; U1[b + 1] = t1; U1[b] = t0; }
                    auto rr = __builtin_amdgcn_permlane32_swap(__float_as_uint(g), __float_as_uint(g), false, false);
                    const float glo = __uint_as_float(rr[0]), ghi = __uint_as_float(rr[1]);
                    T[G] = glo * ghi; part[G] = hi ? 1.f : ghi; }
                float run = carry;
#pragma unroll
                for (int G = 7; G >= 0; --G) { const int b = 4 * (G & 3); const float F = run * part[G];
                    if (G < 4) { p0[b + 3] *= F; p0[b + 2] *= F * U0[b + 2]; p0[b + 1] *= F * U0[b + 1]; p0[b] *= F * U0[b]; }
                    else       { p1[b + 3] *= F; p1[b + 2] *= F * U1[b + 2]; p1[b + 1] *= F * U1[b + 1]; p1[b] *= F * U1[b]; }
                    run *= T[G]; }
                carry = run;
            }
            PK4(p0, 0, pa0); PK4(p0, 8, pa1); PK4(p1, 0, pa2); PK4(p1, 8, pa3);
            SBAR();
            pv_tile(o, vb0 + buf * SHM_V, pa0, pa1, pa2, pa3);
#if defined(ATT_PROBE) && ATT_PROBE == 2
            { bf16x8 z = {}; asm volatile("" : "+v"(z)); pv_tile(o, vb0 + buf * SHM_V, z, z, z, z); }
#endif
        }
    };
#if defined(ATT_PROBE) && ATT_PROBE == 3
#define VOTE_X() __syncthreads()
#else
#define VOTE_X()
#endif
#define VOTE(i_) ({ VOTE_X(); bool go_ = true; if (MODE == 1) { if (lane == 0) flg[((i_) & 1) * 8 + wid] = alive ? 1 : 0; __syncthreads(); go_ = __any(flg[((i_) & 1) * 8 + (lane & 7)] != 0) != 0; } else __syncthreads(); go_; })
    if (!DEEP) {
        for (int i = 0; i < NT; ++i) {
            if (i + 1 < NT) SLOAD(sa, TILE(i + 1));
            step(i, i & 1);
            if (i + 1 < NT) SWRITE(sa, (i & 1) ^ 1);
            if (!VOTE(i)) break;
        }
    } else
    for (int i = 0; i < NT; i += 2) {
        if (i + 2 < NT) SLOAD(sa, TILE(i + 2));
        step(i, 0);
        if (i + 1 < NT) SWRITE(sb, 1);
        if (!VOTE(i) || i + 1 >= NT) break;
        if (i + 3 < NT) SLOAD(sb, TILE(i + 3));
        step(i + 1, 1);
        if (i + 2 < NT) SWRITE(sa, 0);
        if (!VOTE(i + 1)) break;
    }
#undef VOTE
#undef TILE
#undef SLOAD
#undef SWRITE
    float rli[16];
    if (MODE == 0) {
        if (hi == 0) { li_l[r32] = l_reg; lsep[(size_t)qpos * lse_stride] = m_reg + __builtin_amdgcn_logf(l_reg); }
        asm volatile("s_waitcnt lgkmcnt(0)" ::: "memory");
#pragma unroll
        for (int r = 0; r < 16; ++r) rli[r] = __builtin_amdgcn_rcpf(li_l[crow(r, hi)]);
    } else {
#pragma unroll
        for (int r = 0; r < 16; ++r) rli[r] = 1.f;
    }
    GAS bf16* Ow = Op + (size_t)qlo * opitch;
#if defined(ATT_PROBE) && ATT_PROBE == 4
    for (int rep_ = 0; rep_ < 2; ++rep_)
#endif
    {
        ALAS unsigned short* ot = (ALAS unsigned short*)(lds + wid * 8192);
#pragma unroll
        for (int r = 0; r < 16; ++r) { const int orow = crow(r, hi);
#pragma unroll
            for (int d0 = 0; d0 < 4; ++d0) { const float v = o[d0][r] * rli[r]; ot[orow * 128 + d0 * 32 + r32] = (unsigned short)cvtpk(v, v); } }
        asm volatile("s_waitcnt lgkmcnt(0)" ::: "memory");
#pragma unroll
        for (int i = 0; i < 8; ++i) { const int row = i * 4 + (lane >> 4), ch = lane & 15;
            const u32x4 w = *(const ALAS u32x4*)(ot + row * 128 + ch * 8);
            *(GAS u32x4*)(Ow + (size_t)row * opitch + ch * 8) = w; }
    }
    __syncthreads();
}
}

#ifndef MK_N_LAUNCHES
#define MK_N_LAUNCHES 1
#endif
constexpr int NWAVES = 8;
constexpr int BATCH = 4, SEQ = 4096, DM = 2048, DFF = 8192, M = BATCH * SEQ;
constexpr int NIN0 = 5120, NQKV = 6144;
constexpr float RMS_EPS = 1e-6f, LN_EPS = 1e-5f;
constexpr float QSCALE = 0.08838834764831845f * 1.4426950408889634f;
constexpr size_t MiB = 1u << 20;
constexpr size_t WS_WIN = 2 * MiB, WS_WOUT = 22 * MiB, WS_W1_0 = 30 * MiB, WS_W2_0 = 62 * MiB;
constexpr size_t WS_SBIN = 2 * MiB, WS_SBOUT = 26 * MiB, WS_W1_1 = 34 * MiB, WS_W2_1 = 66 * MiB;
constexpr size_t WS_RX = 1 * MiB;
constexpr size_t WS_XR = 98 * MiB;
constexpr size_t WS_YH = 162 * MiB;
constexpr size_t WS_BIG = 226 * MiB;
constexpr size_t WS_END = 482 * MiB;
constexpr int LDS_BYTES = 147456;
constexpr int N_PHASES = 16;

#define LAS __attribute__((address_space(3)))
typedef unsigned short bf16;
typedef unsigned v4u __attribute__((ext_vector_type(4)));
typedef unsigned v2u __attribute__((ext_vector_type(2)));
typedef float f32x4 __attribute__((ext_vector_type(4)));
typedef short bf16x8 __attribute__((ext_vector_type(8)));
#define LDS_WAIT() asm volatile("s_waitcnt lgkmcnt(0)" ::: "memory")
__device__ __forceinline__ unsigned f2bf(float f) { unsigned u = __builtin_bit_cast(unsigned, f); return (u + 0x7fffu + ((u >> 16) & 1u)) >> 16; }
__device__ __forceinline__ unsigned pk2(float lo, float hi) { return f2bf(lo) | (f2bf(hi) << 16); }
__device__ __forceinline__ float bflo(unsigned w) { return __builtin_bit_cast(float, w << 16); }
__device__ __forceinline__ float bfhi(unsigned w) { return __builtin_bit_cast(float, w & 0xffff0000u); }
__device__ __forceinline__ float wave_sum(float v) {
#pragma unroll
    for (int o = 1; o < 64; o <<= 1) v += __shfl_xor(v, o);
    return v;
}
__device__ __forceinline__ void p0_transpose_item(const float* W, int K, int N, GAS bf16* WT, LAS float* scr, int item, int lane, const float* gk = nullptr) {
    const int nblk = N / 64, kb = item / nblk, nb = item % nblk, k0 = 64 * kb, n0 = 64 * nb;
    const int kl = lane >> 4, n4 = (lane & 15) * 4;
    f32x4 v[16];
#pragma unroll
    for (int i = 0; i < 16; ++i) v[i] = __builtin_nontemporal_load((const f32x4*)(W + (size_t)(k0 + 4 * i + kl) * N + n0 + n4));
#pragma unroll
    for (int i = 0; i < 16; ++i) { const float gg = gk ? gk[k0 + 4 * i + kl] : 1.f; LAS float* s = scr + (4 * i + kl) * 65 + n4; s[0] = v[i].x * gg; s[1] = v[i].y * gg; s[2] = v[i].z * gg; s[3] = v[i].w * gg; }
    LDS_WAIT(); asm volatile("" ::: "memory");
    const int c = lane & 7;
#pragma unroll
    for (int j = 0; j < 8; ++j) { const int n = (lane >> 3) + 8 * j; const LAS float* s = scr + (8 * c) * 65 + n;
        v4u o; o.x = pk2(s[0 * 65], s[1 * 65]); o.y = pk2(s[2 * 65], s[3 * 65]); o.z = pk2(s[4 * 65], s[5 * 65]); o.w = pk2(s[6 * 65], s[7 * 65]);
#ifdef CONV_NT
        __builtin_nontemporal_store(o, (GAS v4u*)(WT + (size_t)(n0 + n) * K + k0 + 8 * c)); }
#else
        *(GAS v4u*)(WT + (size_t)(n0 + n) * K + k0 + 8 * c) = o; }
#endif
    LDS_WAIT(); asm volatile("" ::: "memory");
}
#define XB_TMO      128
#define XB_XCNT(j)  (256  + 64 * (j))
#define XB_XSUB(j)  (1280 + 64 * (j))
#define XB_XGEN(j)  (2304 + 64 * (j))
#define XB_TOP      3328
#define XB_TOPGEN   3392
#define XCD_BAR_WORDS 3456
#define XB_SPIN_CAP (1u << 18)

__device__ __forceinline__ unsigned xb_ld(unsigned* p)              { return __hip_atomic_load(p, __ATOMIC_RELAXED, __HIP_MEMORY_SCOPE_AGENT); }
__device__ __forceinline__ unsigned xb_add(unsigned* p, unsigned v) { return __hip_atomic_fetch_add(p, v, __ATOMIC_RELAXED, __HIP_MEMORY_SCOPE_AGENT); }
__device__ __forceinline__ unsigned xb_xcc_id() { return (unsigned)__builtin_amdgcn_s_getreg((3 << 11) | 20) & 0xFu; }
#define XB_SPIN(cond, bar) do { unsigned _sp = 0; while (cond) { __builtin_amdgcn_s_sleep(1); \
    if ((++_sp & 255u) == 0u) { if (xb_ld(&(bar)[XB_TMO])) break; if (_sp > XB_SPIN_CAP) { atomicAdd(&(bar)[XB_TMO], 1u); break; } } } } while (0)

struct XcdBarrier {
    unsigned* bar; unsigned x;
    volatile LAS unsigned* st;
};

__device__ __forceinline__ XcdBarrier xcd_barrier_post(unsigned* bar, volatile LAS unsigned* st) {
    XcdBarrier b; b.bar = bar; b.x = xb_xcc_id(); b.st = st;
    if (threadIdx.x == 0) (void)xb_add(&bar[XB_XCNT(b.x)], 1u);
    return b;
}
__device__ __forceinline__ void xcd_barrier_complete(unsigned* bar, unsigned x, unsigned& nloc, unsigned& nx) {
    const unsigned G = gridDim.x * gridDim.y * gridDim.z;
    unsigned sum, cnt, mine, sp = 0u;
    for (;;) {
        sum = 0u; cnt = 0u; mine = 0u;
#pragma unroll
        for (unsigned j = 0; j < 16; ++j) { const unsigned c = xb_ld(&bar[XB_XCNT(j)]); sum += c; cnt += (c > 0u) ? 1u : 0u; mine = (j == x) ? c : mine; }
        if (sum == G) break;
        __builtin_amdgcn_s_sleep(1);
        if ((++sp & 255u) == 0u) { if (xb_ld(&bar[XB_TMO])) break; if (sp > XB_SPIN_CAP) { atomicAdd(&bar[XB_TMO], 1u); break; } }
    }
    nloc = mine > 0u ? mine : 1u; nx = cnt > 0u ? cnt : 1u;
}

__device__ __forceinline__ void xcd_barrier(const XcdBarrier& b) {
    asm volatile("s_waitcnt vmcnt(0)" ::: "memory");
    __syncthreads();
    if (threadIdx.x == 0) {
        unsigned* bar = b.bar;
        __builtin_amdgcn_s_waitcnt(0);
        unsigned nloc = b.st[0], nx = b.st[1];
        if (nloc == 0u) { xcd_barrier_complete(bar, b.x, nloc, nx); b.st[0] = nloc; b.st[1] = nx; }
        const unsigned old = xb_add(&bar[XB_XSUB(b.x)], 1u);
        const unsigned gen = old / nloc;
        if (old + 1u == (gen + 1u) * nloc) {
            __builtin_amdgcn_fence(__ATOMIC_RELEASE, "agent");
            asm volatile("s_waitcnt vmcnt(0)" ::: "memory");
            const unsigned og = xb_add(&bar[XB_TOP], 1u);
            const unsigned tg = og / nx;
            if (og + 1u == (tg + 1u) * nx) xb_add(&bar[XB_TOPGEN], 1u);
            else XB_SPIN(xb_ld(&bar[XB_TOPGEN]) == tg, bar);
            __builtin_amdgcn_fence(__ATOMIC_ACQUIRE, "agent");
            xb_add(&bar[XB_XGEN(b.x)], 1u);
            asm volatile("s_waitcnt vmcnt(0)" ::: "memory");
        } else {
            XB_SPIN(xb_ld(&bar[XB_XGEN(b.x)]) == gen, bar);
            __builtin_amdgcn_fence(__ATOMIC_ACQUIRE, "agent");
            asm volatile("s_waitcnt vmcnt(0)" ::: "memory");
        }
    }
    __syncthreads();
}

struct Args { const float* in[15]; float* out; unsigned char* ws; int ph_lo, ph_hi; };

__global__ void __launch_bounds__(NWAVES * 64, 2) mk_fwd(Args args) {
    extern __shared__ __attribute__((aligned(16))) unsigned char lds_raw[];
    LAS unsigned char* lds = (LAS unsigned char*)lds_raw;
#ifdef LAYOUT_SHIFT
    asm volatile("s_nop 0\n s_nop 0\n s_nop 0\n s_nop 0\n s_nop 0\n s_nop 0\n s_nop 0\n s_nop 0\n s_nop 0\n s_nop 0\n s_nop 0\n s_nop 0\n s_nop 0\n s_nop 0\n s_nop 0\n s_nop 0\n s_nop 0");
#endif
    const int G = gridDim.x, bx = blockIdx.x;
    const int vcu = (G % 8 == 0) ? (bx % 8) * (G / 8) + bx / 8 : bx;
    volatile LAS unsigned* xst = (volatile LAS unsigned*)(lds + 139264);
    if (threadIdx.x < 2) xst[threadIdx.x] = 0u;
    __syncthreads();
    unsigned* barw = (unsigned*)args.ws;
    XcdBarrier xbar; xbar.bar = barw; xbar.x = 0; xbar.st = xst;
    const float* x_in = args.in[0];
    float* out = args.out;

#ifdef TEST_PH
    { const int ph = TEST_PH;
#else
    for (int ph = args.ph_lo; ph < args.ph_hi; ++ph) {
#endif
#ifndef PROBE_MASK
#define PROBE_MASK 0
#endif
        for (int rep = 0; rep < (((PROBE_MASK >> ph) & 1) ? 2 : 1); ++rep) {
        const int tid = opaque_tid(), lane = tid & 63, wave = __builtin_amdgcn_readfirstlane(tid >> 6);
        const int gw = vcu * NWAVES + wave, NGW = G * NWAVES;
        unsigned long long wsv = (unsigned long long)args.ws; asm volatile("" : "+s"(wsv));
        GAS unsigned char* ws = (GAS unsigned char*)wsv;
        GAS bf16* YH = (GAS bf16*)(ws + WS_YH);
        GAS bf16* Z = (GAS bf16*)(ws + WS_BIG);
        GAS bf16* CAT = (GAS bf16*)(ws + WS_BIG + 160 * MiB);
        GAS float* LSE = (GAS float*)(ws + WS_BIG + 224 * MiB);
        GAS bf16* OB4 = (GAS bf16*)(ws + WS_YH);
        GAS bf16* OB16 = (GAS bf16*)(ws + WS_YH + 32 * MiB);
        GAS bf16* ABUF = (GAS bf16*)(ws + WS_BIG);
        GAS bf16* QKV = (GAS bf16*)(ws + WS_BIG);
        GAS bf16* OBUF = (GAS bf16*)(ws + WS_BIG + 192 * MiB);
        if (ph == 0) {
            if (bx == 0) for (int i = tid; i < XCD_BAR_WORDS; i += NWAVES * 64) barw[i] = 0u;
            LAS float* scr = (LAS float*)(lds + wave * 16640);
            constexpr int I0 = (DM / 64) * (NIN0 / 64), I1 = (DM / 64) * (DM / 64), I4 = (DM / 64) * (DFF / 64), I5 = (DFF / 64) * (DM / 64);
            constexpr int NITEMS = I0 + I1 + I4 + I5;
            for (int it = gw; it < NITEMS; it += NGW) {
                int r = it;
                if (r < I0) { p0_transpose_item(args.in[5], DM, NIN0, (GAS bf16*)(ws + WS_WIN), scr, r, lane, args.in[1]); continue; } r -= I0;
                if (r < I1) { p0_transpose_item(args.in[10], DM, DM, (GAS bf16*)(ws + WS_WOUT), scr, r, lane); continue; } r -= I1;
                if (r < I4) { p0_transpose_item(args.in[13], DM, DFF, (GAS bf16*)(ws + WS_W1_0), scr, r, lane, args.in[3]); continue; } r -= I4;
                p0_transpose_item(args.in[14], DFF, DM, (GAS bf16*)(ws + WS_W2_0), scr, r, lane);
            }
            GAS bf16* XR0 = (GAS bf16*)(ws + WS_XR); GAS float* RX0 = (GAS float*)(ws + WS_RX);
            for (int m = gw; m < M; m += NGW) {
                const float* xr = x_in + (size_t)m * DM + lane * 8; f32x4 v[8]; float ss = 0.f;
#pragma unroll
                for (int j = 0; j < 4; ++j) { v[2 * j] = __builtin_nontemporal_load((const f32x4*)(xr + 512 * j)); v[2 * j + 1] = __builtin_nontemporal_load((const f32x4*)(xr + 512 * j + 4)); }
#pragma unroll
                for (int j = 0; j < 8; ++j) ss += (v[j].x * v[j].x + v[j].y * v[j].y) + (v[j].z * v[j].z + v[j].w * v[j].w);
                const float rs = 1.f / sqrtf(wave_sum(ss) * (1.f / DM) + RMS_EPS);
                if (lane == 0) RX0[m] = rs;
#pragma unroll
                for (int j = 0; j < 4; ++j) { const f32x4 a = v[2 * j], b = v[2 * j + 1];
                    v4u o; o.x = pk2(a.x, a.y); o.y = pk2(a.z, a.w); o.z = pk2(b.x, b.y); o.w = pk2(b.z, b.w);
                    *(GAS v4u*)(XR0 + (size_t)m * DM + lane * 8 + 512 * j) = o; }
            }
        } else if (ph == 1 || ph == 4 || ph == 6 || ph == 7 || ph == 9 || ph == 11 || ph == 13 || ph == 14) {
            pg8::Gemm g; pg8::EpiGen E; E.gelu_tiles = 0; E.sc_lo = 0; E.sc_hi = 0; E.sc = 1.f; E.relu2 = 0; E.rs = nullptr;
            const GAS bf16* XRA = (const GAS bf16*)(ws + WS_XR); const GAS float* RXA = (const GAS float*)(ws + WS_RX);
            if (ph == 1)       { g = pg8::Gemm{XRA, (const GAS bf16*)(ws + WS_WIN), M, NIN0, DM}; E.rs = RXA; E.O = Z; E.ldc = NIN0; E.gelu_tiles = 8; E.sc_lo = 8; E.sc_hi = 12; E.sc = QSCALE; }
            else if (ph == 4)  { g = pg8::Gemm{CAT, (const GAS bf16*)(ws + WS_WOUT), M, DM, DM}; E.O = YH; E.ldc = DM; }
            else if (ph == 6)  { g = pg8::Gemm{XRA, (const GAS bf16*)(ws + WS_W1_0), M, DFF, DM}; E.rs = RXA; E.O = ABUF; E.ldc = DFF; E.relu2 = 1; }
            else if (ph == 7)  { g = pg8::Gemm{ABUF, (const GAS bf16*)(ws + WS_W2_0), M, DM, DFF}; E.O = YH; E.ldc = DM; }
            else if (ph == 9)  { g = pg8::Gemm{XRA, (const GAS bf16*)(ws + WS_SBIN), M, NQKV, DM}; E.rs = RXA; E.O = QKV; E.ldc = NQKV; E.sc_lo = 0; E.sc_hi = 8; E.sc = QSCALE; }
            else if (ph == 11) { g = pg8::Gemm{OBUF, (const GAS bf16*)(ws + WS_SBOUT), M, DM, DM}; E.O = YH; E.ldc = DM; }
            else if (ph == 13) { g = pg8::Gemm{XRA, (const GAS bf16*)(ws + WS_W1_1), M, DFF, DM}; E.rs = RXA; E.O = ABUF; E.ldc = DFF; E.relu2 = 1; }
            else               { g = pg8::Gemm{ABUF, (const GAS bf16*)(ws + WS_W2_1), M, DM, DFF}; E.O = YH; E.ldc = DM; }
            #ifndef WGM_FFN1
#define WGM_FFN1 4
#endif
#ifndef WGM_IN
#define WGM_IN 4
#endif
            #ifdef ALT_XCD_MAP
            const int cmap = (bx / 32) + (bx % 32) * 8;
#else
            const int cmap = bx;
#endif
            #ifndef REV_MASK
#define REV_MASK 16512
#endif
            pg8::StaticOrder S; S.init(g.M, g.N, G, cmap, (g.N == DFF) ? WGM_FFN1 : ((g.N == DM) ? 4 : WGM_IN), (REV_MASK >> ph) & 1);
            #ifndef GEMM_ALIGN
#define GEMM_ALIGN true
#endif
#ifndef GEMM_SP2
#define GEMM_SP2 true
#endif
            pg8::gemm_phase<pg8::EpiGen, pg8::StaticOrder, GEMM_ALIGN, GEMM_SP2>(lds, g, S, E);
        } else if (ph == 2) {
            for (int it = vcu; it < 1536; it += G) {
                const int br = it / 512, rem = it % 512, b = rem / 128, h = (rem / 16) % 8, w = rem % 16;
                const int r = (br == 0) ? 1 : (br == 1 ? 4 : 16), nqb = 16 / r, rho = w / nqb, qb = w % nqb;
                const GAS bf16* Qp = Z + (size_t)(b * SEQ + rho) * NIN0 + 2048 + h * 128;
                GAS bf16* Op; size_t opitch;
                if (br == 0) { Op = CAT + (size_t)(b * SEQ + rho) * DM + 1024 + h * 128; opitch = (size_t)r * DM; }
                else { Op = (br == 1 ? OB4 : OB16) + (size_t)(b * SEQ + rho) * 1024 + h * 128; opitch = (size_t)r * 1024; }
                GAS float* lsep = LSE + (size_t)br * M * 8 + (size_t)(b * SEQ + rho) * 8 + h;
                const float slope2 = exp2f(-(float)(h + 1)) * (float)r * 1.4426950408889634f;
                att::attn_unit<0>((LAS char*)lds, Qp, Qp + 1024, Qp + 2048, (size_t)r * NIN0, Op, opitch, lsep, r * 8, qb * 256, slope2);
            }
        } else if (ph == 3) {
            LAS bf16* Wt = (LAS bf16*)lds;
            LAS bf16* Vt = (LAS bf16*)(lds + 34816);
            LAS float* stat = (LAS float*)(lds + 69632);
            const float* ln_g = args.in[6]; const float* ln_b = args.in[7]; const float* sw = args.in[8]; const float* sb = args.in[9];
            for (int v = vcu; v < 2 * (M / 128); v += G) {
                const int u = v >> 1, half = v & 1;
                const int R0 = u * 128;
                {
                    const int row = tid >> 2, q = tid & 3; const GAS bf16* p = Z + (size_t)(R0 + row) * NIN0 + 1024 + q * 256; float s = 0.f, s2 = 0.f;
#pragma unroll 4
                    for (int j = 0; j < 32; ++j) { const v4u w = *(const GAS v4u*)(p + j * 8);
                        const float a0 = bflo(w.x), a1 = bfhi(w.x), a2 = bflo(w.y), a3 = bfhi(w.y), a4 = bflo(w.z), a5 = bfhi(w.z), a6 = bflo(w.w), a7 = bfhi(w.w);
                        s += ((a0 + a1) + (a2 + a3)) + ((a4 + a5) + (a6 + a7)); s2 += ((a0 * a0 + a1 * a1) + (a2 * a2 + a3 * a3)) + ((a4 * a4 + a5 * a5) + (a6 * a6 + a7 * a7)); }
                    s += __shfl_xor(s, 1); s += __shfl_xor(s, 2); s2 += __shfl_xor(s2, 1); s2 += __shfl_xor(s2, 2);
                    const float mu = s * (1.f / 1024.f), var = fmaxf(s2 * (1.f / 1024.f) - mu * mu, 0.f);
                    if (q == 0) { stat[row * 2] = mu; stat[row * 2 + 1] = 1.f / sqrtf(var + LN_EPS); }
                }
                __syncthreads();
                for (int gg = 0; gg < 4; ++gg) { const int g = half * 4 + gg;
                    {
                        const int i = tid >> 2, c0 = (tid & 3) * 32; const float* wp = sw + ((size_t)g * 128 + i) * 128 + c0;
#pragma unroll
                        for (int j = 0; j < 4; ++j) { const f32x4 a = *(const f32x4*)(wp + 8 * j), b = *(const f32x4*)(wp + 8 * j + 4); const int c = c0 + 8 * j;
                            v4u o; o.x = pk2(c + 0 <= i ? a.x : 0.f, c + 1 <= i ? a.y : 0.f); o.y = pk2(c + 2 <= i ? a.z : 0.f, c + 3 <= i ? a.w : 0.f);
                            o.z = pk2(c + 4 <= i ? b.x : 0.f, c + 5 <= i ? b.y : 0.f); o.w = pk2(c + 6 <= i ? b.z : 0.f, c + 7 <= i ? b.w : 0.f);
                            *(LAS v4u*)(Wt + i * 136 + c) = o; }
                    }
                    {
                        const int j = tid >> 2, d0 = (tid & 3) * 32; const GAS bf16* p = Z + (size_t)(R0 + j) * NIN0 + 1024 + g * 128 + d0;
                        const float mu = stat[j * 2], rs = stat[j * 2 + 1];
#pragma unroll
                        for (int c = 0; c < 4; ++c) { const v4u w = *(const GAS v4u*)(p + 8 * c); const unsigned ww[4] = {w.x, w.y, w.z, w.w};
#pragma unroll
                            for (int e = 0; e < 4; ++e) { const int d = d0 + 8 * c + 2 * e;
                                const float v0 = (bflo(ww[e]) - mu) * rs * ln_g[g * 128 + d] + ln_b[g * 128 + d], v1 = (bfhi(ww[e]) - mu) * rs * ln_g[g * 128 + d + 1] + ln_b[g * 128 + d + 1];
                                Vt[d * 136 + j] = (bf16)f2bf(v0); Vt[(d + 1) * 136 + j] = (bf16)f2bf(v1); } }
                    }
                    __syncthreads();
                    {
                        const int fr = lane & 15, fq = lane >> 4; f32x4 acc[8];
#pragma unroll
                        for (int nt = 0; nt < 8; ++nt) acc[nt] = (f32x4){0.f, 0.f, 0.f, 0.f};
#pragma unroll
                        for (int ks = 0; ks < 4; ++ks) { const bf16x8 a = *(const LAS bf16x8*)(Wt + (16 * wave + fr) * 136 + ks * 32 + fq * 8);
#pragma unroll
                            for (int nt = 0; nt < 8; ++nt) { const bf16x8 b = *(const LAS bf16x8*)(Vt + (nt * 16 + fr) * 136 + ks * 32 + fq * 8);
                                acc[nt] = __builtin_amdgcn_mfma_f32_16x16x32_bf16(b, a, acc[nt], 0, 0, 0); } }
                        const int i = 16 * wave + fr; const float bias = sb[g * 128 + i];
#pragma unroll
                        for (int nt = 0; nt < 8; ++nt) { const int d = nt * 16 + 4 * fq; const v2u uu = *(const GAS v2u*)(Z + (size_t)(R0 + i) * NIN0 + g * 128 + d);
                            v2u o; o.x = pk2(bflo(uu.x) * (acc[nt][0] + bias), bfhi(uu.x) * (acc[nt][1] + bias)); o.y = pk2(bflo(uu.y) * (acc[nt][2] + bias), bfhi(uu.y) * (acc[nt][3] + bias));
                            *(GAS v2u*)(CAT + (size_t)(R0 + i) * DM + g * 128 + d) = o; }
                    }
                    __syncthreads();
                }
                {
                    const int row = R0 + (tid >> 2), q = tid & 3;
                    { const int h = half * 4 + q;
                        const float l0 = LSE[(size_t)row * 8 + h], l1 = LSE[(size_t)M * 8 + (size_t)row * 8 + h], l2 = LSE[(size_t)2 * M * 8 + (size_t)row * 8 + h];
                        const float mx = fmaxf(l0, fmaxf(l1, l2)); float w0 = exp2f(l0 - mx), w1 = exp2f(l1 - mx), w2 = exp2f(l2 - mx); const float inv = 1.f / (w0 + w1 + w2); w0 *= inv; w1 *= inv; w2 *= inv;
                        GAS bf16* c = CAT + (size_t)row * DM + 1024 + h * 128; const GAS bf16* o4 = OB4 + (size_t)row * 1024 + h * 128; const GAS bf16* o16 = OB16 + (size_t)row * 1024 + h * 128;
#pragma unroll 4
                        for (int d = 0; d < 128; d += 8) { const v4u a = *(const GAS v4u*)(c + d), b = *(const GAS v4u*)(o4 + d), e = *(const GAS v4u*)(o16 + d);
                            v4u o; o.x = pk2(w0 * bflo(a.x) + w1 * bflo(b.x) + w2 * bflo(e.x), w0 * bfhi(a.x) + w1 * bfhi(b.x) + w2 * bfhi(e.x));
                            o.y = pk2(w0 * bflo(a.y) + w1 * bflo(b.y) + w2 * bflo(e.y), w0 * bfhi(a.y) + w1 * bfhi(b.y) + w2 * bfhi(e.y));
                            o.z = pk2(w0 * bflo(a.z) + w1 * bflo(b.z) + w2 * bflo(e.z), w0 * bfhi(a.z) + w1 * bfhi(b.z) + w2 * bfhi(e.z));
                            o.w = pk2(w0 * bflo(a.w) + w1 * bflo(b.w) + w2 * bflo(e.w), w0 * bfhi(a.w) + w1 * bfhi(b.w) + w2 * bfhi(e.w));
                            *(GAS v4u*)(c + d) = o; } }
                }
                __syncthreads();
            }
        } else if (ph == 10) {
            for (int it = vcu; it < 512; it += G) {
                const int bh = it / 8, xq = it % 8, b = bh / 16, h = bh % 16;
                const GAS bf16* Qp = QKV + (size_t)(b * SEQ) * NQKV + h * 128;
                GAS bf16* Op = OBUF + (size_t)(b * SEQ) * DM + h * 128;
                att::attn_unit<1>((LAS char*)lds, Qp, Qp + 2048, Qp + 4096, (size_t)NQKV, Op, (size_t)DM, nullptr, 0, (15 - xq) * 256, 0.f);
                att::attn_unit<1>((LAS char*)lds, Qp, Qp + 2048, Qp + 4096, (size_t)NQKV, Op, (size_t)DM, nullptr, 0, xq * 256, 0.f);
            }
        } else {
            const float* gpost; const float* gnext;
            if (ph == 5)       { gpost = args.in[2];      gnext = args.in[3]; }
            else if (ph == 8)  { gpost = args.in[4];      gnext = args.in[1] + DM; }
            else if (ph == 12) { gpost = args.in[2] + DM; gnext = args.in[3] + DM; }
            else               { gpost = args.in[4] + DM; gnext = nullptr; }
            GAS bf16* XR = (GAS bf16*)(ws + WS_XR);
            if (ph == 8) {
                LAS float* scr = (LAS float*)(lds + wave * 16640);
                constexpr int I2 = (DM / 64) * (NQKV / 64), I3 = (DM / 64) * (DM / 64), I4 = (DM / 64) * (DFF / 64), I5 = (DFF / 64) * (DM / 64);
                constexpr int NITEMS = I2 + I3 + I4 + I5;
                for (int it = gw; it < NITEMS; it += NGW) {
                    int r = it;
                    if (r < I2) { p0_transpose_item(args.in[11], DM, NQKV, (GAS bf16*)(ws + WS_SBIN), scr, r, lane, args.in[1] + DM); continue; } r -= I2;
                    if (r < I3) { p0_transpose_item(args.in[12], DM, DM, (GAS bf16*)(ws + WS_SBOUT), scr, r, lane); continue; } r -= I3;
                    if (r < I4) { p0_transpose_item(args.in[13] + (size_t)DM * DFF, DM, DFF, (GAS bf16*)(ws + WS_W1_1), scr, r, lane, args.in[3] + DM); continue; } r -= I4;
                    p0_transpose_item(args.in[14] + (size_t)DM * DFF, DFF, DM, (GAS bf16*)(ws + WS_W2_1), scr, r, lane);
                }
            }
            for (int m = gw; m < M; m += NGW) {
                GAS bf16* yr = YH + (size_t)m * DM + lane * 8; GAS bf16* xr = XR + (size_t)m * DM + lane * 8;
                f32x4 v[8]; v4u yw[4]; float ssy = 0.f;
#pragma unroll
                for (int j = 0; j < 4; ++j) yw[j] = __builtin_nontemporal_load((const GAS v4u*)(yr + 512 * j));
#pragma unroll
                for (int j = 0; j < 4; ++j) { const v4u w = __builtin_nontemporal_load((const GAS v4u*)(xr + 512 * j));
                    v[2 * j] = (f32x4){bflo(w.x), bfhi(w.x), bflo(w.y), bfhi(w.y)}; v[2 * j + 1] = (f32x4){bflo(w.z), bfhi(w.z), bflo(w.w), bfhi(w.w)}; }
                f32x4 y[8];
#pragma unroll
                for (int j = 0; j < 4; ++j) { y[2 * j] = (f32x4){bflo(yw[j].x), bfhi(yw[j].x), bflo(yw[j].y), bfhi(yw[j].y)}; y[2 * j + 1] = (f32x4){bflo(yw[j].z), bfhi(yw[j].z), bflo(yw[j].w), bfhi(yw[j].w)}; }
#pragma unroll
                for (int j = 0; j < 8; ++j) ssy += (y[j].x * y[j].x + y[j].y * y[j].y) + (y[j].z * y[j].z + y[j].w * y[j].w);
                const float ry = 1.f / sqrtf(wave_sum(ssy) * (1.f / DM) + RMS_EPS);
                float ssx = 0.f;
#pragma unroll
                for (int j = 0; j < 8; ++j) { const f32x4 gp = *(const f32x4*)(gpost + lane * 8 + 512 * (j >> 1) + 4 * (j & 1)); v[j] = v[j] + y[j] * ry * gp;
                    ssx += (v[j].x * v[j].x + v[j].y * v[j].y) + (v[j].z * v[j].z + v[j].w * v[j].w); }
                if (gnext) {
#pragma unroll
                    for (int j = 0; j < 4; ++j) { v4u o; o.x = pk2(v[2 * j].x, v[2 * j].y); o.y = pk2(v[2 * j].z, v[2 * j].w); o.z = pk2(v[2 * j + 1].x, v[2 * j + 1].y); o.w = pk2(v[2 * j + 1].z, v[2 * j + 1].w);
                        *(GAS v4u*)(xr + 512 * j) = o; }
                    const float rx = 1.f / sqrtf(wave_sum(ssx) * (1.f / DM) + RMS_EPS);
                    if (lane == 0) ((GAS float*)(ws + WS_RX))[m] = rx;
                } else {
                    float* orow = out + (size_t)m * DM + lane * 8;
#pragma unroll
                    for (int j = 0; j < 8; ++j) __builtin_nontemporal_store(v[j], (f32x4*)(orow + 512 * (j >> 1) + 4 * (j & 1)));
                }
            }
        }
        if (PROBE_MASK) __syncthreads();
        }
        if (ph + 1 < args.ph_hi) {
            if (ph == args.ph_lo) { cooperative_groups::this_grid().sync(); xbar = xcd_barrier_post(barw, xst); }
            else xcd_barrier(xbar);
        }
    }
}

extern "C" void kernel_launch(void* const* d_in, const int* in_sizes, int n_in, void* d_out, int out_size, void* d_ws, size_t ws_size, hipStream_t stream) {
    static int grid = 0;
    if (grid == 0) {
        if (n_in != 15 || in_sizes[0] != M * DM || out_size != M * DM || ws_size < WS_END) { fprintf(stderr, "kernel_launch: unexpected shapes (n_in %d, in0 %d, out %d, ws %zu)\n", n_in, n_in > 0 ? in_sizes[0] : -1, out_size, ws_size); grid = -1; return; }
        int dev = 0, cus = 0, per_cu = 0;
        (void)hipGetDevice(&dev); (void)hipDeviceGetAttribute(&cus, hipDeviceAttributeMultiprocessorCount, dev);
        if (hipFuncSetAttribute((const void*)mk_fwd, hipFuncAttributeMaxDynamicSharedMemorySize, LDS_BYTES) != hipSuccess) { fprintf(stderr, "kernel_launch: hipFuncSetAttribute failed\n"); grid = -1; return; }
        if (hipOccupancyMaxActiveBlocksPerMultiprocessor(&per_cu, (const void*)mk_fwd, NWAVES * 64, LDS_BYTES) != hipSuccess || per_cu < 1) { fprintf(stderr, "kernel_launch: occupancy query says %d\n", per_cu); per_cu = 1; }
        (void)hipGetLastError();
        grid = cus > 0 ? cus : 256;
    }
    if (grid < 0) return;
    Args a{};
    for (int i = 0; i < 15; ++i) a.in[i] = (const float*)d_in[i];
    a.out = (float*)d_out; a.ws = (unsigned char*)d_ws;
#if MK_N_LAUNCHES == 1
    a.ph_lo = 0; a.ph_hi = N_PHASES;
    void* kargs[] = {&a};
    hipError_t e = hipLaunchCooperativeKernel((const void*)mk_fwd, dim3(grid), dim3(NWAVES * 64), kargs, LDS_BYTES, stream);
    if (e != hipSuccess) fprintf(stderr, "kernel_launch: cooperative launch failed: %s (grid %d)\n", hipGetErrorString(e), grid);
#else
    for (int p = 0; p < N_PHASES; ++p) { a.ph_lo = p; a.ph_hi = p + 1; hipLaunchKernelGGL(mk_fwd, dim3(grid), dim3(NWAVES * 64), LDS_BYTES, stream, a); }
#endif
}
```

```cpp
#include <hip/hip_runtime.h>
#include <hip/hip_cooperative_groups.h>
#include <cstdio>
#include <cstdint>
#define GAS __attribute__((address_space(1)))
__device__ __forceinline__ int opaque_tid() { int t = (int)threadIdx.x; asm volatile("" : "+v"(t)); return t; }
namespace pg8 {
#define PG8_LAS __attribute__((address_space(3)))
typedef unsigned short bf16_t;
typedef short bf16x8 __attribute__((ext_vector_type(8)));
typedef float f32x4 __attribute__((ext_vector_type(4)));
typedef unsigned u32x4 __attribute__((ext_vector_type(4)));
constexpr int BM = 256, BK = 64, HALF = 128, HTB = HALF * BK * 2  , STAGE_BYTES = 8 * HTB, NXCD = 8, WGM = 4;

__host__ __device__ __forceinline__ int lds_byte(int r, int c) { const int st = (r >> 4) * 2 + (c >> 5), rr = r & 15, cc = c & 31, ob = rr * 64 + cc * 2; return st * 1024 + (ob ^ (((ob >> 9) & 1) << 5)); }
__host__ __device__ __forceinline__ void stage_rc(int b, int& R, int& C) { const int st = b / 1024, sb = b % 1024, swz = sb ^ (((sb >> 9) & 1) << 5); R = (st >> 1) * 16 + swz / 64; C = (st & 1) * 32 + (swz % 64) / 2; }
__host__ __device__ __forceinline__ int perm32(int rho) { const int n = rho >> 4, i = rho & 15; return 8 * (i >> 2) + 4 * n + (i & 3); }

struct Unit { int pm, pn; };
struct Gemm { const GAS bf16_t* A; const GAS bf16_t* Bt; int M, N, K; };

struct StaticOrder {
    int nM, nN, nwg, G, c, wgm, rev;
    __host__ __device__ void init(int M, int N, int G_, int c_, int wgm_ = WGM, int rev_ = 0) { nM = M / BM; nN = N / BM; nwg = nM * nN; G = G_; c = c_; wgm = wgm_; rev = rev_; }
    __host__ __device__ bool next(int i, Unit& u) const {
        const long L = (long)i * G + c; if (L >= nwg) return false;
        int wgid = (int)L; { const int q = nwg / NXCD, r = nwg % NXCD, xcd = wgid % NXCD; int off = wgid / NXCD; if (rev) off = (xcd < r ? q : q - 1) - off;
            wgid = (xcd < r ? xcd * (q + 1) : r * (q + 1) + (xcd - r) * q) + off; }
        const int nig = wgm * nN, gid = wgid / nig, fm = gid * wgm, gsz = (nM - fm) < wgm ? (nM - fm) : wgm;
        u.pm = fm + ((wgid % nig) % gsz); u.pn = (wgid % nig) / gsz; return true;
    }
    __device__ __forceinline__ void a_ready(const Unit&) const {}
    __device__ __forceinline__ void done(const Unit&) const {}
};

__device__ __forceinline__ unsigned cvt_pk_bf16(float lo, float hi) { unsigned r; asm volatile("v_cvt_pk_bf16_f32 %0, %1, %2" : "=v"(r) : "v"(lo), "v"(hi)); return r; }
typedef float f32x2 __attribute__((ext_vector_type(2)));
__device__ __forceinline__ f32x2 gelu_pk(f32x2 v) {
    const f32x2 av = __builtin_elementwise_abs(v), d = av * 0.2316418882f + 1.0f;
    f32x2 t; t.x = __builtin_amdgcn_rcpf(d.x); t.y = __builtin_amdgcn_rcpf(d.y);
    f32x2 q = t * 0.5307027145f + (-0.7265760135f); q = q * t + 0.7107068705f; q = q * t + (-0.142248368f); q = q * t + 0.127414796f; q = q * t;
    const f32x2 s = (v * v) * (-0.72134752044f);
    f32x2 e; e.x = __builtin_amdgcn_exp2f(s.x); e.y = __builtin_amdgcn_exp2f(s.y);
    const f32x2 m = v * (q * e), r = v - m;
    f32x2 o; o.x = v.x < 0.f ? m.x : r.x; o.y = v.y < 0.f ? m.y : r.y; return o;
}

struct EpiGen {
    static constexpr bool PERM = true, AFTER_DRAIN = false;
    GAS bf16_t* O; int ldc; int gelu_tiles; int sc_lo, sc_hi; float sc; int relu2; const GAS float* rs;
    __device__ __forceinline__ void pre(const Unit& u, PG8_LAS unsigned char* lds, int wid, int wr, int lane, int ui) const {
        if (rs) {
#pragma unroll
            for (int ai = 0; ai < 2; ++ai)
                __builtin_amdgcn_global_load_lds((const GAS unsigned*)(rs + (size_t)u.pm * BM + ai * HALF + wr * 64 + lane), (PG8_LAS unsigned*)(lds + 131072 + (ui & 1) * 4096 + wid * 512 + ai * 256), 4, 0, 0);
        }
    }
    __device__ __forceinline__ void operator()(const f32x4 (&acc)[2][2][4][2], const Unit& u, int wr, int wc, int fr, int fq, PG8_LAS unsigned char* lds, int wid, int ui) const {
        const PG8_LAS float* rsl = (const PG8_LAS float*)(lds + 131072 + (ui & 1) * 4096 + wid * 512);
        const int row0 = u.pm * BM + wr * 64 + fr, col0 = u.pn * BM + wc * 32 + 8 * fq;
        const bool do_gelu = u.pn < gelu_tiles;
        const float s = (u.pn >= sc_lo && u.pn < sc_hi) ? sc : 1.f;
#pragma unroll
        for (int ai = 0; ai < 2; ++ai)
#pragma unroll
            for (int m = 0; m < 4; ++m) { GAS bf16_t* rowp = O + (size_t)(row0 + ai * HALF + m * 16) * ldc + col0; const float rsc = rs ? rsl[ai * 64 + m * 16 + fr] : 1.f;
#pragma unroll
                for (int bj = 0; bj < 2; ++bj) { f32x4 v0 = acc[ai][bj][m][0], v1 = acc[ai][bj][m][1];
                    if (rs) { v0 = v0 * rsc; v1 = v1 * rsc; }
                    if (do_gelu) { f32x2 a = gelu_pk((f32x2){v0[0], v0[1]}), b = gelu_pk((f32x2){v0[2], v0[3]}), c = gelu_pk((f32x2){v1[0], v1[1]}), d = gelu_pk((f32x2){v1[2], v1[3]});
                        v0 = (f32x4){a.x, a.y, b.x, b.y}; v1 = (f32x4){c.x, c.y, d.x, d.y}; }
                    if (relu2) {
#pragma unroll
                        for (int j = 0; j < 4; ++j) { const float t0 = fmaxf(v0[j], 0.f), t1 = fmaxf(v1[j], 0.f); v0[j] = t0 * t0; v1[j] = t1 * t1; } }
                    if (s != 1.f) { v0 = v0 * s; v1 = v1 * s; }
                    u32x4 w; w.x = cvt_pk_bf16(v0[0], v0[1]); w.y = cvt_pk_bf16(v0[2], v0[3]); w.z = cvt_pk_bf16(v1[0], v1[1]); w.w = cvt_pk_bf16(v1[2], v1[3]);
                    #ifdef EPI_NT
                    __builtin_nontemporal_store(w, (GAS u32x4*)(rowp + bj * HALF)); } }
#else
                    *(GAS u32x4*)(rowp + bj * HALF) = w; } }
#endif
    }
};

template <class Epi, class Sched, bool ALIGN_EPI = false, bool SP2 = false>
__device__ __forceinline__ void gemm_phase(PG8_LAS unsigned char* lds, const Gemm g, const Sched& S, const Epi& E) {
    const int tid = opaque_tid(), wid = __builtin_amdgcn_readfirstlane(tid >> 6), lane = tid & 63, wr = wid >> 2, wc = wid & 3, fr = lane & 15, fq = lane >> 4;
    const int K = g.K, nt = K / BK;
    unsigned voffA[2], voffB[2];
#pragma unroll
    for (int i = 0; i < 2; ++i) { int R, C; stage_rc(tid * 16 + i * 8192, R, C); const int Rb = Epi::PERM ? ((R & ~31) + perm32(R & 31)) : R;
        voffA[i] = (unsigned)(R * K + C) * 2u; voffB[i] = (unsigned)(Rb * K + C) * 2u; }
    const size_t kstep = (size_t)(BK * 2);
    const size_t hstep = (size_t)HALF * K * 2;
    const size_t tstep = 2 * hstep;
    const unsigned ldsw = (unsigned)wid * 1024u;
    const int aoff = lds_byte(wr * 64 + fr, fq * 8), boff = lds_byte(wc * 32 + fr, fq * 8);
#ifndef PG8_PFD
#define PG8_PFD 0
#endif
    const int pfi = tid;
    const bool pfB = (pfi >> 8) != 0;
    const unsigned pfoff = (unsigned)(((pfi >> 7) & 1) * (HALF * K * 2) + (pfi & 127) * (K * 2));
#define PG8_PF(kt) do { if (PG8_PFD) { int kt_ = (kt); const GAS char* pa_ = cA; const GAS char* pb_ = cB; if (kt_ >= nt) { kt_ -= nt; pa_ = nA; pb_ = nB; } \
        const GAS char* p_ = (pfB ? pb_ : pa_) + pfoff + (size_t)kt_ * kstep; \
        __builtin_amdgcn_global_load_lds((const GAS unsigned*)p_, (PG8_LAS unsigned*)(lds + 131072 + wid * 256), 4, 0, 0); } } while (0)
#define PG8_WAIT_VL() do { if (PG8_PFD) PG8_WAIT_V(9); else PG8_WAIT_V(8); } while (0)
#define PG8_SA(b, h) (((b) * 2 + (h)) * HTB)
#define PG8_SB(b, h) ((4 + (b) * 2 + (h)) * HTB)
#ifndef PG8_AUX_A
#define PG8_AUX_A 0
#endif
#ifndef PG8_AUX_B
#define PG8_AUX_B 0
#endif
#define PG8_STAGE(bufoff, gbase, voff) do { _Pragma("unroll") for (int _i = 0; _i < 2; ++_i) { \
        if ((bufoff) < 4 * HTB) __builtin_amdgcn_global_load_lds((const GAS unsigned*)((const GAS char*)(gbase) + (voff)[_i]), (PG8_LAS unsigned*)(lds + (bufoff) + ldsw + _i * 8192), 16, 0, PG8_AUX_A); \
        else __builtin_amdgcn_global_load_lds((const GAS unsigned*)((const GAS char*)(gbase) + (voff)[_i]), (PG8_LAS unsigned*)(lds + (bufoff) + ldsw + _i * 8192), 16, 0, PG8_AUX_B); } } while (0)
#define PG8_LDA(dst, b, h) do { _Pragma("unroll") for (int m = 0; m < 4; ++m) _Pragma("unroll") for (int k = 0; k < 2; ++k) dst[m][k] = *(const PG8_LAS bf16x8*)(lds + PG8_SA(b, h) + aoff + m * 2048 + k * 1024); } while (0)
#define PG8_LDB(dst, b, h) do { _Pragma("unroll") for (int n = 0; n < 2; ++n) _Pragma("unroll") for (int k = 0; k < 2; ++k) dst[n][k] = *(const PG8_LAS bf16x8*)(lds + PG8_SB(b, h) + boff + n * 2048 + k * 1024); } while (0)
#define PG8_MMA(ai, bj, At, Bt) do { __builtin_amdgcn_s_setprio(1); _Pragma("unroll") for (int m = 0; m < 4; ++m) _Pragma("unroll") for (int n = 0; n < 2; ++n) _Pragma("unroll") for (int k = 0; k < 2; ++k) \
        acc[ai][bj][m][n] = __builtin_amdgcn_mfma_f32_16x16x32_bf16(Bt[n][k], At[m][k], acc[ai][bj][m][n], 0, 0, 0); __builtin_amdgcn_s_setprio(0); } while (0)
#define PG8_WAIT_V(n) asm volatile("s_waitcnt vmcnt(" #n ")" ::: "memory")
#define PG8_WAIT_L(n) asm volatile("s_waitcnt lgkmcnt(" #n ")" ::: "memory")
#define PG8_BAR __builtin_amdgcn_s_barrier()
#define PG8_SCHED __builtin_amdgcn_sched_barrier(0)
    Unit cur, nxt; int ui = 0;
    if (!S.next(0, cur)) return;
    f32x4 acc[2][2][4][2];
#pragma unroll
    for (int a = 0; a < 2; ++a)
#pragma unroll
        for (int b = 0; b < 2; ++b)
#pragma unroll
            for (int m = 0; m < 4; ++m)
#pragma unroll
                for (int n = 0; n < 2; ++n) acc[a][b][m][n] = (f32x4){0.f, 0.f, 0.f, 0.f};
    bf16x8 At[4][2], B0[2][2], B1[2][2];
    const GAS char* cA = (const GAS char*)g.A + (size_t)cur.pm * tstep; const GAS char* cB = (const GAS char*)g.Bt + (size_t)cur.pn * tstep;
    S.a_ready(cur);
    if constexpr (SP2) {
        PG8_STAGE(PG8_SB(0, 0), cB, voffB); PG8_STAGE(PG8_SB(0, 1), cB + hstep, voffB); PG8_STAGE(PG8_SA(0, 0), cA, voffA); PG8_STAGE(PG8_SA(0, 1), cA + hstep, voffA);
        if (wr == 1) PG8_BAR;
        PG8_WAIT_V(2); PG8_BAR;
        PG8_STAGE(PG8_SB(1, 0), cB + kstep, voffB); PG8_STAGE(PG8_SA(1, 0), cA + kstep, voffA); PG8_STAGE(PG8_SB(1, 1), cB + hstep + kstep, voffB);
        PG8_WAIT_V(6); PG8_BAR;
    } else {
        PG8_STAGE(PG8_SB(0, 0), cB, voffB); PG8_STAGE(PG8_SA(0, 0), cA, voffA); PG8_STAGE(PG8_SB(0, 1), cB + hstep, voffB); PG8_STAGE(PG8_SA(0, 1), cA + hstep, voffA);
        if (wr == 1) PG8_BAR;
        PG8_WAIT_V(4); PG8_BAR;
        PG8_STAGE(PG8_SB(1, 0), cB + kstep, voffB); PG8_STAGE(PG8_SA(1, 0), cA + kstep, voffA); PG8_STAGE(PG8_SB(1, 1), cB + hstep + kstep, voffB);
        PG8_WAIT_V(6); PG8_BAR;
    }
    for (;;) {
        const bool has_next = S.next(ui + 1, nxt);
        E.pre(cur, lds, wid, wr, lane, ui);
        const GAS char* nA = has_next ? (const GAS char*)g.A + (size_t)nxt.pm * tstep : cA; const GAS char* nB = has_next ? (const GAS char*)g.Bt + (size_t)nxt.pn * tstep : cB;
        for (int t = 0; t < nt; t += 2) {
            const bool last = (t == nt - 2);
            const GAS char* a1 = cA + (size_t)(t + 1) * kstep;
            const GAS char* a2 = last ? nA : cA + (size_t)(t + 2) * kstep; const GAS char* b2 = last ? nB : cB + (size_t)(t + 2) * kstep;
            const GAS char* a3 = a2 + kstep; const GAS char* b3 = b2 + kstep;
            if (last && has_next) S.a_ready(nxt);
            if constexpr (SP2) {
            PG8_LDB(B0, 0, 0); PG8_LDB(B1, 0, 1); PG8_SCHED; PG8_LDA(At, 0, 0); PG8_STAGE(PG8_SA(1, 1), a1 + hstep, voffA);
            PG8_WAIT_VL(); PG8_WAIT_L(0); PG8_BAR; PG8_MMA(0, 0, At, B0); PG8_MMA(0, 1, At, B1); PG8_BAR; PG8_SCHED;
            PG8_LDA(At, 0, 1); PG8_STAGE(PG8_SB(0, 0), b2, voffB); PG8_STAGE(PG8_SB(0, 1), b2 + hstep, voffB); PG8_STAGE(PG8_SA(0, 0), a2, voffA); PG8_PF(t + PG8_PFD);
            PG8_WAIT_VL(); PG8_WAIT_L(0); PG8_BAR; PG8_MMA(1, 0, At, B0); PG8_MMA(1, 1, At, B1); PG8_BAR; PG8_SCHED;
            PG8_LDB(B0, 1, 0); PG8_LDB(B1, 1, 1); PG8_SCHED; PG8_LDA(At, 1, 0); PG8_STAGE(PG8_SA(0, 1), a2 + hstep, voffA);
            PG8_WAIT_VL(); PG8_WAIT_L(0); PG8_BAR; PG8_MMA(0, 0, At, B0); PG8_MMA(0, 1, At, B1); PG8_BAR; PG8_SCHED;
            PG8_LDA(At, 1, 1); PG8_STAGE(PG8_SB(1, 0), b3, voffB); PG8_STAGE(PG8_SB(1, 1), b3 + hstep, voffB); PG8_STAGE(PG8_SA(1, 0), a3, voffA); PG8_PF(t + 1 + PG8_PFD);
            PG8_WAIT_VL(); PG8_WAIT_L(0); PG8_BAR; PG8_MMA(1, 0, At, B0); PG8_MMA(1, 1, At, B1); PG8_BAR; PG8_SCHED;
            } else {
            PG8_LDB(B0, 0, 0); PG8_SCHED; PG8_LDA(At, 0, 0); PG8_STAGE(PG8_SA(1, 1), a1 + hstep, voffA);
            PG8_WAIT_L(8); PG8_BAR; PG8_WAIT_L(0); PG8_MMA(0, 0, At, B0); PG8_BAR; PG8_SCHED;
            PG8_LDB(B1, 0, 1); PG8_STAGE(PG8_SB(0, 0), b2, voffB);
            PG8_BAR; PG8_WAIT_L(0); PG8_MMA(0, 1, At, B1); PG8_BAR;
            PG8_LDA(At, 0, 1); PG8_STAGE(PG8_SA(0, 0), a2, voffA);
            PG8_BAR; PG8_WAIT_L(0); PG8_MMA(1, 0, At, B0); PG8_BAR; PG8_SCHED;
            PG8_STAGE(PG8_SB(0, 1), b2 + hstep, voffB);
            PG8_WAIT_V(6); PG8_BAR; PG8_MMA(1, 1, At, B1); PG8_BAR;
            PG8_LDB(B0, 1, 0); PG8_SCHED; PG8_LDA(At, 1, 0); PG8_STAGE(PG8_SA(0, 1), a2 + hstep, voffA);
            PG8_WAIT_L(8); PG8_BAR; PG8_WAIT_L(0); PG8_MMA(0, 0, At, B0); PG8_BAR; PG8_SCHED;
            PG8_LDB(B1, 1, 1); PG8_STAGE(PG8_SB(1, 0), b3, voffB);
            PG8_BAR; PG8_WAIT_L(0); PG8_MMA(0, 1, At, B1); PG8_BAR;
            PG8_LDA(At, 1, 1); PG8_STAGE(PG8_SA(1, 0), a3, voffA);
            PG8_BAR; PG8_WAIT_L(0); PG8_MMA(1, 0, At, B0); PG8_BAR; PG8_SCHED;
            PG8_STAGE(PG8_SB(1, 1), b3 + hstep, voffB);
            PG8_WAIT_V(6); PG8_BAR; PG8_MMA(1, 1, At, B1); PG8_BAR;
            }
        }
        if constexpr (ALIGN_EPI) { if (wr == 0) PG8_BAR; }
        if constexpr (!Epi::AFTER_DRAIN) { E(acc, cur, wr, wc, fr, fq, lds, wid, ui);
#ifdef PROBE_EPI
            asm volatile("" ::: "memory"); E(acc, cur, wr, wc, fr, fq, lds, wid, ui);
#endif
            S.done(cur); }
        if (!has_next) break;
#pragma unroll
        for (int a = 0; a < 2; ++a)
#pragma unroll
            for (int b = 0; b < 2; ++b)
#pragma unroll
                for (int m = 0; m < 4; ++m)
#pragma unroll
                    for (int n = 0; n < 2; ++n) acc[a][b][m][n] = (f32x4){0.f, 0.f, 0.f, 0.f};
        cur = nxt; cA = nA; cB = nB; ++ui;
        if constexpr (ALIGN_EPI) { if (wr == 1) PG8_BAR; }
    }
    PG8_WAIT_V(0);
    if constexpr (!ALIGN_EPI) { if (wr == 0) PG8_BAR; }
    PG8_BAR;
    if constexpr (Epi::AFTER_DRAIN) { E.fused(acc, cur, wr, wc, fr, fq, lds, wid, lane); S.done(cur); }
#undef PG8_SA
#undef PG8_SB
#undef PG8_STAGE
#undef PG8_LDA
#undef PG8_LDB
#undef PG8_MMA
#undef PG8_WAIT_V
#undef PG8_WAIT_L
#undef PG8_BAR
#undef PG8_SCHED
#undef PG8_PF
#undef PG8_WAIT_VL
}
}

namespace att {
#define ALAS __attribute__((address_space(3)))
typedef unsigned short bf16;
typedef short bf16x8 __attribute__((ext_vector_type(8)));
typedef short s16x4 __attribute__((ext_vector_type(4)));
typedef float f32x16 __attribute__((ext_vector_type(16)));
typedef float f32x4 __attribute__((ext_vector_type(4)));
typedef unsigned u32x4 __attribute__((ext_vector_type(4)));
constexpr int SHM_V = 16384, SHM_K = 16384;
#define KSWZ(row, colB) ((row) * 256 + ((colB) ^ (((row) & 7) << 4)))
#define SBAR() __builtin_amdgcn_sched_barrier(0)
__device__ __forceinline__ int v_st(int k, int c) { const int kk = (k & ~0xC) | ((k & 4) << 1) | ((k & 8) >> 1); return ((kk >> 3) * 4 + (c >> 5)) * 512 + ((kk & 7) * 32 + (c & 31)) * 2; }
__device__ __forceinline__ int v_rd_base(int lane) { return ((lane & 3) << 3) | (((lane >> 2) & 3) << 6) | (((lane >> 4) & 1) << 5) | (((lane >> 5) & 1) << 8); }
__device__ __forceinline__ int crow(int r, int hi) { return (r & 3) + 8 * (r >> 2) + 4 * hi; }
__device__ __forceinline__ unsigned cvtpk(float lo, float hi) { unsigned r; asm volatile("v_cvt_pk_bf16_f32 %0, %1, %2" : "=v"(r) : "v"(lo), "v"(hi)); return r; }

__device__ __forceinline__ void qkt(f32x16& p0, f32x16& p1, const ALAS char* Kb, int r32, int hi, const bf16x8* qr) {
    p0 = f32x16{}; p1 = f32x16{};
    const ALAS char* kb[4];
#pragma unroll
    for (int dd = 0; dd < 4; ++dd) kb[dd] = Kb + KSWZ(r32, (dd * 16 + hi * 8) * 2);
#ifdef ATT_PRIO
    __builtin_amdgcn_s_setprio(1);
#endif
#pragma unroll
    for (int d0 = 0; d0 < 8; ++d0) { const ALAS char* a = kb[d0 & 3] + (d0 >> 2) * 128;
        bf16x8 b0 = *reinterpret_cast<const ALAS bf16x8*>(a);
        bf16x8 b1 = *reinterpret_cast<const ALAS bf16x8*>(a + 32 * 256);
        p0 = __builtin_amdgcn_mfma_f32_32x32x16_bf16(b0, qr[d0], p0, 0, 0, 0);
        p1 = __builtin_amdgcn_mfma_f32_32x32x16_bf16(b1, qr[d0], p1, 0, 0, 0); }
#ifdef ATT_PRIO
    __builtin_amdgcn_s_setprio(0);
#endif
}
__device__ __forceinline__ void pv_tile(f32x16* o, int vb, bf16x8 pa0, bf16x8 pa1, bf16x8 pa2, bf16x8 pa3) {
#define TRRD(dst, off) asm volatile("ds_read_b64_tr_b16 %0, %1 offset:%2" : "=&v"(dst) : "v"(vb), "i"(off) : "memory")
#define PV_D2(da, db) do { s16x4 l0, l1, l2, l3, h0, h1, h2, h3, m0, m1, m2, m3, g0, g1, g2, g3; constexpr int a_ = (da) * 512, b_ = (db) * 512; \
        TRRD(l0, a_); TRRD(h0, a_ + 2048); TRRD(m0, b_); TRRD(g0, b_ + 2048); TRRD(l1, a_ + 4096); TRRD(h1, a_ + 6144); TRRD(m1, b_ + 4096); TRRD(g1, b_ + 6144); \
        TRRD(l2, a_ + 8192); TRRD(h2, a_ + 10240); TRRD(m2, b_ + 8192); TRRD(g2, b_ + 10240); TRRD(l3, a_ + 12288); TRRD(h3, a_ + 14336); TRRD(m3, b_ + 12288); TRRD(g3, b_ + 14336); \
        asm volatile("s_waitcnt lgkmcnt(0)" ::: "memory"); SBAR(); \
        o[da] = __builtin_amdgcn_mfma_f32_32x32x16_bf16(pa0, (bf16x8){l0[0], l0[1], l0[2], l0[3], h0[0], h0[1], h0[2], h0[3]}, o[da], 0, 0, 0); \
        o[db] = __builtin_amdgcn_mfma_f32_32x32x16_bf16(pa0, (bf16x8){m0[0], m0[1], m0[2], m0[3], g0[0], g0[1], g0[2], g0[3]}, o[db], 0, 0, 0); \
        o[da] = __builtin_amdgcn_mfma_f32_32x32x16_bf16(pa1, (bf16x8){l1[0], l1[1], l1[2], l1[3], h1[0], h1[1], h1[2], h1[3]}, o[da], 0, 0, 0); \
        o[db] = __builtin_amdgcn_mfma_f32_32x32x16_bf16(pa1, (bf16x8){m1[0], m1[1], m1[2], m1[3], g1[0], g1[1], g1[2], g1[3]}, o[db], 0, 0, 0); \
        o[da] = __builtin_amdgcn_mfma_f32_32x32x16_bf16(pa2, (bf16x8){l2[0], l2[1], l2[2], l2[3], h2[0], h2[1], h2[2], h2[3]}, o[da], 0, 0, 0); \
        o[db] = __builtin_amdgcn_mfma_f32_32x32x16_bf16(pa2, (bf16x8){m2[0], m2[1], m2[2], m2[3], g2[0], g2[1], g2[2], g2[3]}, o[db], 0, 0, 0); \
        o[da] = __builtin_amdgcn_mfma_f32_32x32x16_bf16(pa3, (bf16x8){l3[0], l3[1], l3[2], l3[3], h3[0], h3[1], h3[2], h3[3]}, o[da], 0, 0, 0); \
        o[db] = __builtin_amdgcn_mfma_f32_32x32x16_bf16(pa3, (bf16x8){m3[0], m3[1], m3[2], m3[3], g3[0], g3[1], g3[2], g3[3]}, o[db], 0, 0, 0); } while (0)
#ifdef ATT_PRIO
    __builtin_amdgcn_s_setprio(1);
#endif
    PV_D2(0, 1); PV_D2(2, 3);
#ifdef ATT_PRIO
    __builtin_amdgcn_s_setprio(0);
#endif
#undef PV_D2
#undef TRRD
}
__device__ __forceinline__ float swap_sum(float x) { auto rr = __builtin_amdgcn_permlane32_swap(__float_as_uint(x), __float_as_uint(x), false, false); return __uint_as_float(rr[0]) + __uint_as_float(rr[1]); }
__device__ __forceinline__ float swap_max(float x) { auto rr = __builtin_amdgcn_permlane32_swap(__float_as_uint(x), __float_as_uint(x), false, false); return fmaxf(__uint_as_float(rr[0]), __uint_as_float(rr[1])); }
#define PK4(P, B_, OUT) do { unsigned a0 = cvtpk(P[B_+0], P[B_+1]), a1 = cvtpk(P[B_+2], P[B_+3]); \
        unsigned b0 = cvtpk(P[B_+4], P[B_+5]), b1 = cvtpk(P[B_+6], P[B_+7]); \
        auto r0 = __builtin_amdgcn_permlane32_swap(a0, b0, false, false); auto r1 = __builtin_amdgcn_permlane32_swap(a1, b1, false, false); \
        u32x4 w = {r0[0], r1[0], r0[1], r1[1]}; OUT = *reinterpret_cast<bf16x8*>(&w); } while (0)

template <int MODE>
__device__ __forceinline__ void attn_unit(ALAS char* lds, const GAS bf16* Qp, const GAS bf16* Kp, const GAS bf16* Vp, size_t pitch,
                                          GAS bf16* Op, size_t opitch, GAS float* lsep, int lse_stride, int P0, float slope2) {
    const int tid = opaque_tid(), wid = __builtin_amdgcn_readfirstlane(tid >> 6), lane = tid & 63, r32 = lane & 31, hi = lane >> 5;
    const int qlo = P0 + 32 * wid, qpos = qlo + r32;
    ALAS char* V_lds = lds; ALAS char* K_lds = lds + 2 * SHM_V;
    ALAS float* wsf = (ALAS float*)(lds + 2 * SHM_V + 2 * SHM_K) + wid * 64; ALAS float* li_l = wsf; ALAS float* al_l = wsf + 32;
    const int sr = tid >> 4, sc = (tid & 15) * 8, vst0 = v_st(sr, sc), vst1 = v_st(32 + sr, sc), kws = KSWZ(sr, sc * 2);
    const int vb0 = (int)(unsigned)(size_t)V_lds + v_rd_base(lane);
    int NT, tbase, tstep;
    if (MODE == 0) { const int lowk = P0 - 128; const int jlo = lowk > 0 ? lowk / 64 : 0; const int jhi = (P0 + 255) / 64; NT = jhi - jlo + 1; tbase = jlo; tstep = 1; }
    else { const int jhi = (P0 + 254) / 64; NT = jhi + 1; tbase = jhi; tstep = -1; }
    bf16x8 qr[8];
#pragma unroll
    for (int d0 = 0; d0 < 8; ++d0) qr[d0] = *(const GAS bf16x8*)(Qp + (size_t)qpos * pitch + d0 * 16 + hi * 8);
    bf16x8 sa0, sa1, sa2, sa3, sb0, sb1, sb2, sb3;
#define SLOAD(S, kb_) do { const GAS bf16* k_ = Kp + (size_t)((kb_) + sr) * pitch + sc; const GAS bf16* v_ = Vp + (size_t)((kb_) + sr) * pitch + sc; \
        S##0 = *(const GAS bf16x8*)k_; S##1 = *(const GAS bf16x8*)(k_ + 32 * pitch); S##2 = *(const GAS bf16x8*)v_; S##3 = *(const GAS bf16x8*)(v_ + 32 * pitch); } while (0)
#define SWRITE(S, bf_) do { *(ALAS bf16x8*)(K_lds + (bf_) * SHM_K + kws) = S##0; *(ALAS bf16x8*)(K_lds + (bf_) * SHM_K + kws + 32 * 256) = S##1; \
        *(ALAS bf16x8*)(V_lds + (bf_) * SHM_V + vst0) = S##2; *(ALAS bf16x8*)(V_lds + (bf_) * SHM_V + vst1) = S##3; } while (0)
#define TILE(i_) ((tbase + tstep * (i_)) * 64)
#ifndef DEEP_MASK
#define DEEP_MASK 0
#endif
    constexpr bool DEEP = ((DEEP_MASK >> MODE) & 1) != 0;
    SLOAD(sa, TILE(0)); if (DEEP && NT > 1) SLOAD(sb, TILE(1));
    SWRITE(sa, 0);
    __syncthreads();
#if defined(ATT_PROBE) && ATT_PROBE == 5
    asm volatile("" ::: "memory");
#pragma unroll
    for (int d0 = 0; d0 < 8; ++d0) { qr[d0] = *(const GAS bf16x8*)(Qp + (size_t)qpos * pitch + d0 * 16 + hi * 8); asm volatile("" : "+v"(qr[d0])); }
    SLOAD(sa, TILE(0)); asm volatile("s_waitcnt vmcnt(0)" ::: "memory"); SWRITE(sa, 0);
    __syncthreads();
#endif
    f32x16 o[4] = {};
    float m_reg = -1e30f, l_reg = 0.f, carry = 1.f;
    ALAS int* flg = (ALAS int*)(lds + 2 * SHM_V + 2 * SHM_K + 2048);
    bool alive = true;
    auto step = [&](const int i, const int buf) __attribute__((always_inline)) {
        const int kb = TILE(i);
        alive = (MODE == 0) ? true : (__any(carry != 0.f) != 0);
        const bool act = (MODE == 0) ? (kb <= qlo + 31 && kb + 63 >= qlo - 128) : (kb < qlo + 31 && alive);
        if (act) {
            f32x16 p0, p1; bf16x8 pa0, pa1, pa2, pa3;
            qkt(p0, p1, K_lds + buf * SHM_K, r32, hi, qr);
#if defined(ATT_PROBE) && ATT_PROBE == 1
            asm volatile("" : "+v"(p0), "+v"(p1)); qkt(p0, p1, K_lds + buf * SHM_K, r32, hi, qr);
#endif
            const int dqb = qpos - kb - 4 * hi;
            if (MODE == 0) {
                const float NEG = -__builtin_inff();
#pragma unroll
                for (int r = 0; r < 16; ++r) { const int c = (r & 3) + 8 * (r >> 2); const int d0_ = dqb - c, d1_ = d0_ - 32;
                    p0[r] = ((unsigned)d0_ <= 128u) ? fmaf(-slope2, (float)d0_, p0[r]) : NEG;
                    p1[r] = ((unsigned)d1_ <= 128u) ? fmaf(-slope2, (float)d1_, p1[r]) : NEG; }
                float pmax = p0[0];
#pragma unroll
                for (int r = 1; r < 16; ++r) pmax = fmaxf(pmax, p0[r]);
#pragma unroll
                for (int r = 0; r < 16; ++r) pmax = fmaxf(pmax, p1[r]);
                pmax = swap_max(pmax);
                float mn, alpha;
                if (__all(pmax - m_reg <= 8.f)) { mn = m_reg; alpha = 1.f; } else { mn = fmaxf(m_reg, pmax); alpha = __builtin_amdgcn_exp2f(m_reg - mn); m_reg = mn; }
                float ps = 0.f;
#pragma unroll
                for (int r = 0; r < 16; ++r) { p0[r] = __builtin_amdgcn_exp2f(p0[r] - mn); ps += p0[r]; }
#pragma unroll
                for (int r = 0; r < 16; ++r) { p1[r] = __builtin_amdgcn_exp2f(p1[r] - mn); ps += p1[r]; }
                ps = swap_sum(ps);
                l_reg = l_reg * alpha + ps;
                if (__any(alpha < 1.f)) { if (hi == 0) al_l[r32] = alpha; asm volatile("s_waitcnt lgkmcnt(0)" ::: "memory");
#pragma unroll
                    for (int d_ = 0; d_ < 4; ++d_)
#pragma unroll
                        for (int r = 0; r < 16; ++r) o[d_][r] *= al_l[crow(r, hi)]; }
            } else {
                const bool need_mask = kb + 63 >= qlo;
                f32x16 U0, U1;
#pragma unroll
                for (int r = 0; r < 16; ++r) { U0[r] = __builtin_amdgcn_rcpf(1.f + __builtin_amdgcn_exp2f(p0[r])); U1[r] = __builtin_amdgcn_rcpf(1.f + __builtin_amdgcn_exp2f(p1[r])); }
                if (need_mask) {
#pragma unroll
                    for (int r = 0; r < 16; ++r) { const int c = (r & 3) + 8 * (r >> 2); if (dqb - c <= 0) U0[r] = 1.f; if (dqb - c - 32 <= 0) U1[r] = 1.f; } }
#pragma unroll
                for (int r = 0; r < 16; ++r) { p0[r] = 1.f - U0[r]; p1[r] = 1.f - U1[r]; }
                float T[8], part[8];
#pragma unroll
                for (int G = 0; G < 8; ++G) { const int b = 4 * (G & 3); float g;
                    if (G < 4) { const float t2 = U0[b + 3], t1 = t2 * U0[b + 2], t0 = t1 * U0[b + 1]; g = t0 * U0[b]; U0[b + 2] = t2; U0[b + 1] = t1; U0[b] = t0; }
                    else       { const float t2 = U1[b + 3], t1 = t2 * U1[b + 2], t0 = t1 * U1[b + 1]; g = t0 * U1[b]; U1[b + 2] = t2; U1[b + 1] = t1; U1[b] = t0; }
                    auto rr = __builtin_amdgcn_permlane32_swap(__float_as_uint(g), __float_as_uint(g), false, false);
                    const float glo = __uint_as_float(rr[0]), ghi = __uint_as_float(rr[1]);
                    T[G] = glo * ghi; part[G] = hi ? 1.f : ghi; }
                float run = carry;
#pragma unroll
                for (int G = 7; G >= 0; --G) { const int b = 4 * (G & 3); const float F = run * part[G];
                    if (G < 4) { p0[b + 3] *= F; p0[b + 2] *= F * U0[b + 2]; p0[b + 1] *= F * U0[b + 1]; p0[b] *= F * U0[b]; }
                    else       { p1[b + 3] *= F; p1[b + 2] *= F * U1[b + 2]; p1[b + 1] *= F * U1[b + 1]; p1[b] *= F * U1[b]; }
                    run *= T[G]; }
                carry = run;
            }
            PK4(p0, 0, pa0); PK4(p0, 8, pa1); PK4(p1, 0, pa2); PK4(p1, 8, pa3);
            SBAR();
            pv_tile(o, vb0 + buf * SHM_V, pa0, pa1, pa2, pa3);
#if defined(ATT_PROBE) && ATT_PROBE == 2
            { bf16x8 z = {}; asm volatile("" : "+v"(z)); pv_tile(o, vb0 + buf * SHM_V, z, z, z, z); }
#endif
        }
    };
#if defined(ATT_PROBE) && ATT_PROBE == 3
#define VOTE_X() __syncthreads()
#else
#define VOTE_X()
#endif
#define VOTE(i_) ({ VOTE_X(); bool go_ = true; if (MODE == 1) { if (lane == 0) flg[((i_) & 1) * 8 + wid] = alive ? 1 : 0; __syncthreads(); go_ = __any(flg[((i_) & 1) * 8 + (lane & 7)] != 0) != 0; } else __syncthreads(); go_; })
    if (!DEEP) {
        for (int i = 0; i < NT; ++i) {
            if (i + 1 < NT) SLOAD(sa, TILE(i + 1));
            step(i, i & 1);
            if (i + 1 < NT) SWRITE(sa, (i & 1) ^ 1);
            if (!VOTE(i)) break;
        }
    } else
    for (int i = 0; i < NT; i += 2) {
        if (i + 2 < NT) SLOAD(sa, TILE(i + 2));
        step(i, 0);
        if (i + 1 < NT) SWRITE(sb, 1);
        if (!VOTE(i) || i + 1 >= NT) break;
        if (i + 3 < NT) SLOAD(sb, TILE(i + 3));
        step(i + 1, 1);
        if (i + 2 < NT) SWRITE(sa, 0);
        if (!VOTE(i + 1)) break;
    }
#undef VOTE
#undef TILE
#undef SLOAD
#undef SWRITE
    float rli[16];
    if (MODE == 0) {
        if (hi == 0) { li_l[r32] = l_reg; lsep[(size_t)qpos * lse_stride] = m_reg + __builtin_amdgcn_logf(l_reg); }
        asm volatile("s_waitcnt lgkmcnt(0)" ::: "memory");
#pragma unroll
        for (int r = 0; r < 16; ++r) rli[r] = __builtin_amdgcn_rcpf(li_l[crow(r, hi)]);
    } else {
#pragma unroll
        for (int r = 0; r < 16; ++r) rli[r] = 1.f;
    }
    GAS bf16* Ow = Op + (size_t)qlo * opitch;
#if defined(ATT_PROBE) && ATT_PROBE == 4
    for (int rep_ = 0; rep_ < 2; ++rep_)
#endif
    {
        ALAS unsigned short* ot = (ALAS unsigned short*)(lds + wid * 8192);
#pragma unroll
        for (int r = 0; r < 16; ++r) { const int orow = crow(r, hi);
#pragma unroll
            for (int d0 = 0; d0 < 4; ++d0) { const float v = o[d0][r] * rli[r]; ot[orow * 128 + d0 * 32 + r32] = (unsigned short)cvtpk(v, v); } }
        asm volatile("s_waitcnt lgkmcnt(0)" ::: "memory");
#pragma unroll
        for (int i = 0; i < 8; ++i) { const int row = i * 4 + (lane >> 4), ch = lane & 15;
            const u32x4 w = *(const ALAS u32x4*)(ot + row * 128 + ch * 8);
            *(GAS u32x4*)(Ow + (size_t)row * opitch + ch * 8) = w; }
    }
    __syncthreads();
}
}

#ifndef MK_N_LAUNCHES
#define MK_N_LAUNCHES 1
#endif
constexpr int NWAVES = 8;
constexpr int BATCH = 4, SEQ = 4096, DM = 2048, DFF = 8192, M = BATCH * SEQ;
constexpr int NIN0 = 5120, NQKV = 6144;
constexpr float RMS_EPS = 1e-6f, LN_EPS = 1e-5f;
constexpr float QSCALE = 0.08838834764831845f * 1.4426950408889634f;
constexpr size_t MiB = 1u << 20;
constexpr size_t WS_WIN = 2 * MiB, WS_WOUT = 22 * MiB, WS_W1_0 = 30 * MiB, WS_W2_0 = 62 * MiB;
constexpr size_t WS_SBIN = 2 * MiB, WS_SBOUT = 26 * MiB, WS_W1_1 = 34 * MiB, WS_W2_1 = 66 * MiB;
constexpr size_t WS_RX = 1 * MiB;
constexpr size_t WS_XR = 98 * MiB;
constexpr size_t WS_YH = 162 * MiB;
constexpr size_t WS_BIG = 226 * MiB;
constexpr size_t WS_END = 482 * MiB;
constexpr int LDS_BYTES = 147456;
constexpr int N_PHASES = 16;

#define LAS __attribute__((address_space(3)))
typedef unsigned short bf16;
typedef unsigned v4u __attribute__((ext_vector_type(4)));
typedef unsigned v2u __attribute__((ext_vector_type(2)));
typedef float f32x4 __attribute__((ext_vector_type(4)));
typedef short bf16x8 __attribute__((ext_vector_type(8)));
#define LDS_WAIT() asm volatile("s_waitcnt lgkmcnt(0)" ::: "memory")
__device__ __forceinline__ unsigned f2bf(float f) { unsigned u = __builtin_bit_cast(unsigned, f); return (u + 0x7fffu + ((u >> 16) & 1u)) >> 16; }
__device__ __forceinline__ unsigned pk2(float lo, float hi) { return f2bf(lo) | (f2bf(hi) << 16); }
__device__ __forceinline__ float bflo(unsigned w) { return __builtin_bit_cast(float, w << 16); }
__device__ __forceinline__ float bfhi(unsigned w) { return __builtin_bit_cast(float, w & 0xffff0000u); }
__device__ __forceinline__ float wave_sum(float v) {
#pragma unroll
    for (int o = 1; o < 64; o <<= 1) v += __shfl_xor(v, o);
    return v;
}
__device__ __forceinline__ void p0_transpose_item(const float* W, int K, int N, GAS bf16* WT, LAS float* scr, int item, int lane, const float* gk = nullptr) {
    const int nblk = N / 64, kb = item / nblk, nb = item % nblk, k0 = 64 * kb, n0 = 64 * nb;
    const int kl = lane >> 4, n4 = (lane & 15) * 4;
    f32x4 v[16];
#pragma unroll
    for (int i = 0; i < 16; ++i) v[i] = __builtin_nontemporal_load((const f32x4*)(W + (size_t)(k0 + 4 * i + kl) * N + n0 + n4));
#pragma unroll
    for (int i = 0; i < 16; ++i) { const float gg = gk ? gk[k0 + 4 * i + kl] : 1.f; LAS float* s = scr + (4 * i + kl) * 65 + n4; s[0] = v[i].x * gg; s[1] = v[i].y * gg; s[2] = v[i].z * gg; s[3] = v[i].w * gg; }
    LDS_WAIT(); asm volatile("" ::: "memory");
    const int c = lane & 7;
#pragma unroll
    for (int j = 0; j < 8; ++j) { const int n = (lane >> 3) + 8 * j; const LAS float* s = scr + (8 * c) * 65 + n;
        v4u o; o.x = pk2(s[0 * 65], s[1 * 65]); o.y = pk2(s[2 * 65], s[3 * 65]); o.z = pk2(s[4 * 65], s[5 * 65]); o.w = pk2(s[6 * 65], s[7 * 65]);
#ifdef CONV_NT
        __builtin_nontemporal_store(o, (GAS v4u*)(WT + (size_t)(n0 + n) * K + k0 + 8 * c)); }
#else
        *(GAS v4u*)(WT + (size_t)(n0 + n) * K + k0 + 8 * c) = o; }
#endif
    LDS_WAIT(); asm volatile("" ::: "memory");
}
#define XB_TMO      128
#define XB_XCNT(j)  (256  + 64 * (j))
#define XB_XSUB(j)  (1280 + 64 * (j))
#define XB_XGEN(j)  (2304 + 64 * (j))
#define XB_TOP      3328
#define XB_TOPGEN   3392
#define XCD_BAR_WORDS 3456
#define XB_SPIN_CAP (1u << 18)

__device__ __forceinline__ unsigned xb_ld(unsigned* p)              { return __hip_atomic_load(p, __ATOMIC_RELAXED, __HIP_MEMORY_SCOPE_AGENT); }
__device__ __forceinline__ unsigned xb_add(unsigned* p, unsigned v) { return __hip_atomic_fetch_add(p, v, __ATOMIC_RELAXED, __HIP_MEMORY_SCOPE_AGENT); }
__device__ __forceinline__ unsigned xb_xcc_id() { return (unsigned)__builtin_amdgcn_s_getreg((3 << 11) | 20) & 0xFu; }
#define XB_SPIN(cond, bar) do { unsigned _sp = 0; while (cond) { __builtin_amdgcn_s_sleep(1); \
    if ((++_sp & 255u) == 0u) { if (xb_ld(&(bar)[XB_TMO])) break; if (_sp > XB_SPIN_CAP) { atomicAdd(&(bar)[XB_TMO], 1u); break; } } } } while (0)

struct XcdBarrier {
    unsigned* bar; unsigned x;
    volatile LAS unsigned* st;
};

__device__ __forceinline__ XcdBarrier xcd_barrier_post(unsigned* bar, volatile LAS unsigned* st) {
    XcdBarrier b; b.bar = bar; b.x = xb_xcc_id(); b.st = st;
    if (threadIdx.x == 0) (void)xb_add(&bar[XB_XCNT(b.x)], 1u);
    return b;
}
__device__ __forceinline__ void xcd_barrier_complete(unsigned* bar, unsigned x, unsigned& nloc, unsigned& nx) {
    const unsigned G = gridDim.x * gridDim.y * gridDim.z;
    unsigned sum, cnt, mine, sp = 0u;
    for (;;) {
        sum = 0u; cnt = 0u; mine = 0u;
#pragma unroll
        for (unsigned j = 0; j < 16; ++j) { const unsigned c = xb_ld(&bar[XB_XCNT(j)]); sum += c; cnt += (c > 0u) ? 1u : 0u; mine = (j == x) ? c : mine; }
        if (sum == G) break;
        __builtin_amdgcn_s_sleep(1);
        if ((++sp & 255u) == 0u) { if (xb_ld(&bar[XB_TMO])) break; if (sp > XB_SPIN_CAP) { atomicAdd(&bar[XB_TMO], 1u); break; } }
    }
    nloc = mine > 0u ? mine : 1u; nx = cnt > 0u ? cnt : 1u;
}

__device__ __forceinline__ void xcd_barrier(const XcdBarrier& b) {
    asm volatile("s_waitcnt vmcnt(0)" ::: "memory");
    __syncthreads();
    if (threadIdx.x == 0) {
        unsigned* bar = b.bar;
        __builtin_amdgcn_s_waitcnt(0);
        unsigned nloc = b.st[0], nx = b.st[1];
        if (nloc == 0u) { xcd_barrier_complete(bar, b.x, nloc, nx); b.st[0] = nloc; b.st[1] = nx; }
        const unsigned old = xb_add(&bar[XB_XSUB(b.x)], 1u);
        const unsigned gen = old / nloc;
        if (old + 1u == (gen + 1u) * nloc) {
            __builtin_amdgcn_fence(__ATOMIC_RELEASE, "agent");
            asm volatile("s_waitcnt vmcnt(0)" ::: "memory");
            const unsigned og = xb_add(&bar[XB_TOP], 1u);
            const unsigned tg = og / nx;
            if (og + 1u == (tg + 1u) * nx) xb_add(&bar[XB_TOPGEN], 1u);
            else XB_SPIN(xb_ld(&bar[XB_TOPGEN]) == tg, bar);
            __builtin_amdgcn_fence(__ATOMIC_ACQUIRE, "agent");
            xb_add(&bar[XB_XGEN(b.x)], 1u);
            asm volatile("s_waitcnt vmcnt(0)" ::: "memory");
        } else {
            XB_SPIN(xb_ld(&bar[XB_XGEN(b.x)]) == gen, bar);
            __builtin_amdgcn_fence(__ATOMIC_ACQUIRE, "agent");
            asm volatile("s_waitcnt vmcnt(0)" ::: "memory");
        }
    }
    __syncthreads();
}

struct Args { const float* in[15]; float* out; unsigned char* ws; int ph_lo, ph_hi; };

__global__ void __launch_bounds__(NWAVES * 64, 2) mk_fwd(Args args) {
    extern __shared__ __attribute__((aligned(16))) unsigned char lds_raw[];
    LAS unsigned char* lds = (LAS unsigned char*)lds_raw;
#ifdef LAYOUT_SHIFT
    asm volatile("s_nop 0\n s_nop 0\n s_nop 0\n s_nop 0\n s_nop 0\n s_nop 0\n s_nop 0\n s_nop 0\n s_nop 0\n s_nop 0\n s_nop 0\n s_nop 0\n s_nop 0\n s_nop 0\n s_nop 0\n s_nop 0\n s_nop 0");
#endif
    const int G = gridDim.x, bx = blockIdx.x;
    const int vcu = (G % 8 == 0) ? (bx % 8) * (G / 8) + bx / 8 : bx;
    volatile LAS unsigned* xst = (volatile LAS unsigned*)(lds + 139264);
    if (threadIdx.x < 2) xst[threadIdx.x] = 0u;
    __syncthreads();
    unsigned* barw = (unsigned*)args.ws;
    XcdBarrier xbar; xbar.bar = barw; xbar.x = 0; xbar.st = xst;
    const float* x_in = args.in[0];
    float* out = args.out;

#ifdef TEST_PH
    { const int ph = TEST_PH;
#else
    for (int ph = args.ph_lo; ph < args.ph_hi; ++ph) {
#endif
#ifndef PROBE_MASK
#define PROBE_MASK 0
#endif
        for (int rep = 0; rep < (((PROBE_MASK >> ph) & 1) ? 2 : 1); ++rep) {
        const int tid = opaque_tid(), lane = tid & 63, wave = __builtin_amdgcn_readfirstlane(tid >> 6);
        const int gw = vcu * NWAVES + wave, NGW = G * NWAVES;
        unsigned long long wsv = (unsigned long long)args.ws; asm volatile("" : "+s"(wsv));
        GAS unsigned char* ws = (GAS unsigned char*)wsv;
        GAS bf16* YH = (GAS bf16*)(ws + WS_YH);
        GAS bf16* Z = (GAS bf16*)(ws + WS_BIG);
        GAS bf16* CAT = (GAS bf16*)(ws + WS_BIG + 160 * MiB);
        GAS float* LSE = (GAS float*)(ws + WS_BIG + 224 * MiB);
        GAS bf16* OB4 = (GAS bf16*)(ws + WS_YH);
        GAS bf16* OB16 = (GAS bf16*)(ws + WS_YH + 32 * MiB);
        GAS bf16* ABUF = (GAS bf16*)(ws + WS_BIG);
        GAS bf16* QKV = (GAS bf16*)(ws + WS_BIG);
        GAS bf16* OBUF = (GAS bf16*)(ws + WS_BIG + 192 * MiB);
        if (ph == 0) {
            if (bx == 0) for (int i = tid; i < XCD_BAR_WORDS; i += NWAVES * 64) barw[i] = 0u;
            LAS float* scr = (LAS float*)(lds + wave * 16640);
            constexpr int I0 = (DM / 64) * (NIN0 / 64), I1 = (DM / 64) * (DM / 64), I4 = (DM / 64) * (DFF / 64), I5 = (DFF / 64) * (DM / 64);
            constexpr int NITEMS = I0 + I1 + I4 + I5;
            for (int it = gw; it < NITEMS; it += NGW) {
                int r = it;
                if (r < I0) { p0_transpose_item(args.in[5], DM, NIN0, (GAS bf16*)(ws + WS_WIN), scr, r, lane, args.in[1]); continue; } r -= I0;
                if (r < I1) { p0_transpose_item(args.in[10], DM, DM, (GAS bf16*)(ws + WS_WOUT), scr, r, lane); continue; } r -= I1;
                if (r < I4) { p0_transpose_item(args.in[13], DM, DFF, (GAS bf16*)(ws + WS_W1_0), scr, r, lane, args.in[3]); continue; } r -= I4;
                p0_transpose_item(args.in[14], DFF, DM, (GAS bf16*)(ws + WS_W2_0), scr, r, lane);
            }
            GAS bf16* XR0 = (GAS bf16*)(ws + WS_XR); GAS float* RX0 = (GAS float*)(ws + WS_RX);
            for (int m = gw; m < M; m += NGW) {
                const float* xr = x_in + (size_t)m * DM + lane * 8; f32x4 v[8]; float ss = 0.f;
#pragma unroll
                for (int j = 0; j < 4; ++j) { v[2 * j] = __builtin_nontemporal_load((const f32x4*)(xr + 512 * j)); v[2 * j + 1] = __builtin_nontemporal_load((const f32x4*)(xr + 512 * j + 4)); }
#pragma unroll
                for (int j = 0; j < 8; ++j) ss += (v[j].x * v[j].x + v[j].y * v[j].y) + (v[j].z * v[j].z + v[j].w * v[j].w);
                const float rs = 1.f / sqrtf(wave_sum(ss) * (1.f / DM) + RMS_EPS);
                if (lane == 0) RX0[m] = rs;
#pragma unroll
                for (int j = 0; j < 4; ++j) { const f32x4 a = v[2 * j], b = v[2 * j + 1];
                    v4u o; o.x = pk2(a.x, a.y); o.y = pk2(a.z, a.w); o.z = pk2(b.x, b.y); o.w = pk2(b.z, b.w);
                    *(GAS v4u*)(XR0 + (size_t)m * DM + lane * 8 + 512 * j) = o; }
            }
        } else if (ph == 1 || ph == 4 || ph == 6 || ph == 7 || ph == 9 || ph == 11 || ph == 13 || ph == 14) {
            pg8::Gemm g; pg8::EpiGen E; E.gelu_tiles = 0; E.sc_lo = 0; E.sc_hi = 0; E.sc = 1.f; E.relu2 = 0; E.rs = nullptr;
            const GAS bf16* XRA = (const GAS bf16*)(ws + WS_XR); const GAS float* RXA = (const GAS float*)(ws + WS_RX);
            if (ph == 1)       { g = pg8::Gemm{XRA, (const GAS bf16*)(ws + WS_WIN), M, NIN0, DM}; E.rs = RXA; E.O = Z; E.ldc = NIN0; E.gelu_tiles = 8; E.sc_lo = 8; E.sc_hi = 12; E.sc = QSCALE; }
            else if (ph == 4)  { g = pg8::Gemm{CAT, (const GAS bf16*)(ws + WS_WOUT), M, DM, DM}; E.O = YH; E.ldc = DM; }
            else if (ph == 6)  { g = pg8::Gemm{XRA, (const GAS bf16*)(ws + WS_W1_0), M, DFF, DM}; E.rs = RXA; E.O = ABUF; E.ldc = DFF; E.relu2 = 1; }
            else if (ph == 7)  { g = pg8::Gemm{ABUF, (const GAS bf16*)(ws + WS_W2_0), M, DM, DFF}; E.O = YH; E.ldc = DM; }
            else if (ph == 9)  { g = pg8::Gemm{XRA, (const GAS bf16*)(ws + WS_SBIN), M, NQKV, DM}; E.rs = RXA; E.O = QKV; E.ldc = NQKV; E.sc_lo = 0; E.sc_hi = 8; E.sc = QSCALE; }
            else if (ph == 11) { g = pg8::Gemm{OBUF, (const GAS bf16*)(ws + WS_SBOUT), M, DM, DM}; E.O = YH; E.ldc = DM; }
            else if (ph == 13) { g = pg8::Gemm{XRA, (const GAS bf16*)(ws + WS_W1_1), M, DFF, DM}; E.rs = RXA; E.O = ABUF; E.ldc = DFF; E.relu2 = 1; }
            else               { g = pg8::Gemm{ABUF, (const GAS bf16*)(ws + WS_W2_1), M, DM, DFF}; E.O = YH; E.ldc = DM; }
            #ifndef WGM_FFN1
#define WGM_FFN1 4
#endif
#ifndef WGM_IN
#define WGM_IN 4
#endif
            #ifdef ALT_XCD_MAP
            const int cmap = (bx / 32) + (bx % 32) * 8;
#else
            const int cmap = bx;
#endif
            #ifndef REV_MASK
#define REV_MASK 16512
#endif
            pg8::StaticOrder S; S.init(g.M, g.N, G, cmap, (g.N == DFF) ? WGM_FFN1 : ((g.N == DM) ? 4 : WGM_IN), (REV_MASK >> ph) & 1);
            #ifndef GEMM_ALIGN
#define GEMM_ALIGN true
#endif
#ifndef GEMM_SP2
#define GEMM_SP2 true
#endif
            pg8::gemm_phase<pg8::EpiGen, pg8::StaticOrder, GEMM_ALIGN, GEMM_SP2>(lds, g, S, E);
        } else if (ph == 2) {
            for (int it = vcu; it < 1536; it += G) {
                const int br = it / 512, rem = it % 512, b = rem / 128, h = (rem / 16) % 8, w = rem % 16;
                const int r = (br == 0) ? 1 : (br == 1 ? 4 : 16), nqb = 16 / r, rho = w / nqb, qb = w % nqb;
                const GAS bf16* Qp = Z + (size_t)(b * SEQ + rho) * NIN0 + 2048 + h * 128;
                GAS bf16* Op; size_t opitch;
                if (br == 0) { Op = CAT + (size_t)(b * SEQ + rho) * DM + 1024 + h * 128; opitch = (size_t)r * DM; }
                else { Op = (br == 1 ? OB4 : OB16) + (size_t)(b * SEQ + rho) * 1024 + h * 128; opitch = (size_t)r * 1024; }
                GAS float* lsep = LSE + (size_t)br * M * 8 + (size_t)(b * SEQ + rho) * 8 + h;
                const float slope2 = exp2f(-(float)(h + 1)) * (float)r * 1.4426950408889634f;
                att::attn_unit<0>((LAS char*)lds, Qp, Qp + 1024, Qp + 2048, (size_t)r * NIN0, Op, opitch, lsep, r * 8, qb * 256, slope2);
            }
        } else if (ph == 3) {
            LAS bf16* Wt = (LAS bf16*)lds;
            LAS bf16* Vt = (LAS bf16*)(lds + 34816);
            LAS float* stat = (LAS float*)(lds + 69632);
            const float* ln_g = args.in[6]; const float* ln_b = args.in[7]; const float* sw = args.in[8]; const float* sb = args.in[9];
            for (int v = vcu; v < 2 * (M / 128); v += G) {
                const int u = v >> 1, half = v & 1;
                const int R0 = u * 128;
                {
                    const int row = tid >> 2, q = tid & 3; const GAS bf16* p = Z + (size_t)(R0 + row) * NIN0 + 1024 + q * 256; float s = 0.f, s2 = 0.f;
#pragma unroll 4
                    for (int j = 0; j < 32; ++j) { const v4u w = *(const GAS v4u*)(p + j * 8);
                        const float a0 = bflo(w.x), a1 = bfhi(w.x), a2 = bflo(w.y), a3 = bfhi(w.y), a4 = bflo(w.z), a5 = bfhi(w.z), a6 = bflo(w.w), a7 = bfhi(w.w);
                        s += ((a0 + a1) + (a2 + a3)) + ((a4 + a5) + (a6 + a7)); s2 += ((a0 * a0 + a1 * a1) + (a2 * a2 + a3 * a3)) + ((a4 * a4 + a5 * a5) + (a6 * a6 + a7 * a7)); }
                    s += __shfl_xor(s, 1); s += __shfl_xor(s, 2); s2 += __shfl_xor(s2, 1); s2 += __shfl_xor(s2, 2);
                    const float mu = s * (1.f / 1024.f), var = fmaxf(s2 * (1.f / 1024.f) - mu * mu, 0.f);
                    if (q == 0) { stat[row * 2] = mu; stat[row * 2 + 1] = 1.f / sqrtf(var + LN_EPS); }
                }
                __syncthreads();
                for (int gg = 0; gg < 4; ++gg) { const int g = half * 4 + gg;
                    {
                        const int i = tid >> 2, c0 = (tid & 3) * 32; const float* wp = sw + ((size_t)g * 128 + i) * 128 + c0;
#pragma unroll
                        for (int j = 0; j < 4; ++j) { const f32x4 a = *(const f32x4*)(wp + 8 * j), b = *(const f32x4*)(wp + 8 * j + 4); const int c = c0 + 8 * j;
                            v4u o; o.x = pk2(c + 0 <= i ? a.x : 0.f, c + 1 <= i ? a.y : 0.f); o.y = pk2(c + 2 <= i ? a.z : 0.f, c + 3 <= i ? a.w : 0.f);
                            o.z = pk2(c + 4 <= i ? b.x : 0.f, c + 5 <= i ? b.y : 0.f); o.w = pk2(c + 6 <= i ? b.z : 0.f, c + 7 <= i ? b.w : 0.f);
                            *(LAS v4u*)(Wt + i * 136 + c) = o; }
                    }
                    {
                        const int j = tid >> 2, d0 = (tid & 3) * 32; const GAS bf16* p = Z + (size_t)(R0 + j) * NIN0 + 1024 + g * 128 + d0;
                        const float mu = stat[j * 2], rs = stat[j * 2 + 1];
#pragma unroll
                        for (int c = 0; c < 4; ++c) { const v4u w = *(const GAS v4u*)(p + 8 * c); const unsigned ww[4] = {w.x, w.y, w.z, w.w};
#pragma unroll
                            for (int e = 0; e < 4; ++e) { const int d = d0 + 8 * c + 2 * e;
                                const float v0 = (bflo(ww[e]) - mu) * rs * ln_g[g * 128 + d] + ln_b[g * 128 + d], v1 = (bfhi(ww[e]) - mu) * rs * ln_g[g * 128 + d + 1] + ln_b[g * 128 + d + 1];
                                Vt[d * 136 + j] = (bf16)f2bf(v0); Vt[(d + 1) * 136 + j] = (bf16)f2bf(v1); } }
                    }
                    __syncthreads();
                    {
                        const int fr = lane & 15, fq = lane >> 4; f32x4 acc[8];
#pragma unroll
                        for (int nt = 0; nt < 8; ++nt) acc[nt] = (f32x4){0.f, 0.f, 0.f, 0.f};
#pragma unroll
                        for (int ks = 0; ks < 4; ++ks) { const bf16x8 a = *(const LAS bf16x8*)(Wt + (16 * wave + fr) * 136 + ks * 32 + fq * 8);
#pragma unroll
                            for (int nt = 0; nt < 8; ++nt) { const bf16x8 b = *(const LAS bf16x8*)(Vt + (nt * 16 + fr) * 136 + ks * 32 + fq * 8);
                                acc[nt] = __builtin_amdgcn_mfma_f32_16x16x32_bf16(b, a, acc[nt], 0, 0, 0); } }
                        const int i = 16 * wave + fr; const float bias = sb[g * 128 + i];
#pragma unroll
                        for (int nt = 0; nt < 8; ++nt) { const int d = nt * 16 + 4 * fq; const v2u uu = *(const GAS v2u*)(Z + (size_t)(R0 + i) * NIN0 + g * 128 + d);
                            v2u o; o.x = pk2(bflo(uu.x) * (acc[nt][0] + bias), bfhi(uu.x) * (acc[nt][1] + bias)); o.y = pk2(bflo(uu.y) * (acc[nt][2] + bias), bfhi(uu.y) * (acc[nt][3] + bias));
                            *(GAS v2u*)(CAT + (size_t)(R0 + i) * DM + g * 128 + d) = o; }
                    }
                    __syncthreads();
                }
                {
                    const int row = R0 + (tid >> 2), q = tid & 3;
                    { const int h = half * 4 + q;
                        const float l0 = LSE[(size_t)row * 8 + h], l1 = LSE[(size_t)M * 8 + (size_t)row * 8 + h], l2 = LSE[(size_t)2 * M * 8 + (size_t)row * 8 + h];
                        const float mx = fmaxf(l0, fmaxf(l1, l2)); float w0 = exp2f(l0 - mx), w1 = exp2f(l1 - mx), w2 = exp2f(l2 - mx); const float inv = 1.f / (w0 + w1 + w2); w0 *= inv; w1 *= inv; w2 *= inv;
                        GAS bf16* c = CAT + (size_t)row * DM + 1024 + h * 128; const GAS bf16* o4 = OB4 + (size_t)row * 1024 + h * 128; const GAS bf16* o16 = OB16 + (size_t)row * 1024 + h * 128;
#pragma unroll 4
                        for (int d = 0; d < 128; d += 8) { const v4u a = *(const GAS v4u*)(c + d), b = *(const GAS v4u*)(o4 + d), e = *(const GAS v4u*)(o16 + d);
                            v4u o; o.x = pk2(w0 * bflo(a.x) + w1 * bflo(b.x) + w2 * bflo(e.x), w0 * bfhi(a.x) + w1 * bfhi(b.x) + w2 * bfhi(e.x));
                            o.y = pk2(w0 * bflo(a.y) + w1 * bflo(b.y) + w2 * bflo(e.y), w0 * bfhi(a.y) + w1 * bfhi(b.y) + w2 * bfhi(e.y));
                            o.z = pk2(w0 * bflo(a.z) + w1 * bflo(b.z) + w2 * bflo(e.z), w0 * bfhi(a.z) + w1 * bfhi(b.z) + w2 * bfhi(e.z));
                            o.w = pk2(w0 * bflo(a.w) + w1 * bflo(b.w) + w2 * bflo(e.w), w0 * bfhi(a.w) + w1 * bfhi(b.w) + w2 * bfhi(e.w));
                            *(GAS v4u*)(c + d) = o; } }
                }
                __syncthreads();
            }
        } else if (ph == 10) {
            for (int it = vcu; it < 512; it += G) {
                const int bh = it / 8, xq = it % 8, b = bh / 16, h = bh % 16;
                const GAS bf16* Qp = QKV + (size_t)(b * SEQ) * NQKV + h * 128;
                GAS bf16* Op = OBUF + (size_t)(b * SEQ) * DM + h * 128;
                att::attn_unit<1>((LAS char*)lds, Qp, Qp + 2048, Qp + 4096, (size_t)NQKV, Op, (size_t)DM, nullptr, 0, (15 - xq) * 256, 0.f);
                att::attn_unit<1>((LAS char*)lds, Qp, Qp + 2048, Qp + 4096, (size_t)NQKV, Op, (size_t)DM, nullptr, 0, xq * 256, 0.f);
            }
        } else {
            const float* gpost; const float* gnext;
            if (ph == 5)       { gpost = args.in[2];      gnext = args.in[3]; }
            else if (ph == 8)  { gpost = args.in[4];      gnext = args.in[1] + DM; }
            else if (ph == 12) { gpost = args.in[2] + DM; gnext = args.in[3] + DM; }
            else               { gpost = args.in[4] + DM; gnext = nullptr; }
            GAS bf16* XR = (GAS bf16*)(ws + WS_XR);
            if (ph == 8) {
                LAS float* scr = (LAS float*)(lds + wave * 16640);
                constexpr int I2 = (DM / 64) * (NQKV / 64), I3 = (DM / 64) * (DM / 64), I4 = (DM / 64) * (DFF / 64), I5 = (DFF / 64) * (DM / 64);
                constexpr int NITEMS = I2 + I3 + I4 + I5;
                for (int it = gw; it < NITEMS; it += NGW) {
                    int r = it;
                    if (r < I2) { p0_transpose_item(args.in[11], DM, NQKV, (GAS bf16*)(ws + WS_SBIN), scr, r, lane, args.in[1] + DM); continue; } r -= I2;
                    if (r < I3) { p0_transpose_item(args.in[12], DM, DM, (GAS bf16*)(ws + WS_SBOUT), scr, r, lane); continue; } r -= I3;
                    if (r < I4) { p0_transpose_item(args.in[13] + (size_t)DM * DFF, DM, DFF, (GAS bf16*)(ws + WS_W1_1), scr, r, lane, args.in[3] + DM); continue; } r -= I4;
                    p0_transpose_item(args.in[14] + (size_t)DM * DFF, DFF, DM, (GAS bf16*)(ws + WS_W2_1), scr, r, lane);
                }
            }
            for (int m = gw; m < M; m += NGW) {
                GAS bf16* yr = YH + (size_t)m * DM + lane * 8; GAS bf16* xr = XR + (size_t)m * DM + lane * 8;
                f32x4 v[8]; v4u yw[4]; float ssy = 0.f;
#pragma unroll
                for (int j = 0; j < 4; ++j) yw[j] = __builtin_nontemporal_load((const GAS v4u*)(yr + 512 * j));
#pragma unroll
                for (int j = 0; j < 4; ++j) { const v4u w = __builtin_nontemporal_load((const GAS v4u*)(xr + 512 * j));
                    v[2 * j] = (f32x4){bflo(w.x), bfhi(w.x), bflo(w.y), bfhi(w.y)}; v[2 * j + 1] = (f32x4){bflo(w.z), bfhi(w.z), bflo(w.w), bfhi(w.w)}; }
                f32x4 y[8];
#pragma unroll
                for (int j = 0; j < 4; ++j) { y[2 * j] = (f32x4){bflo(yw[j].x), bfhi(yw[j].x), bflo(yw[j].y), bfhi(yw[j].y)}; y[2 * j + 1] = (f32x4){bflo(yw[j].z), bfhi(yw[j].z), bflo(yw[j].w), bfhi(yw[j].w)}; }
#pragma unroll
                for (int j = 0; j < 8; ++j) ssy += (y[j].x * y[j].x + y[j].y * y[j].y) + (y[j].z * y[j].z + y[j].w * y[j].w);
                const float ry = 1.f / sqrtf(wave_sum(ssy) * (1.f / DM) + RMS_EPS);
                float ssx = 0.f;
#pragma unroll
                for (int j = 0; j < 8; ++j) { const f32x4 gp = *(const f32x4*)(gpost + lane * 8 + 512 * (j >> 1) + 4 * (j & 1)); v[j] = v[j] + y[j] * ry * gp;
                    ssx += (v[j].x * v[j].x + v[j].y * v[j].y) + (v[j].z * v[j].z + v[j].w * v[j].w); }
                if (gnext) {
#pragma unroll
                    for (int j = 0; j < 4; ++j) { v4u o; o.x = pk2(v[2 * j].x, v[2 * j].y); o.y = pk2(v[2 * j].z, v[2 * j].w); o.z = pk2(v[2 * j + 1].x, v[2 * j + 1].y); o.w = pk2(v[2 * j + 1].z, v[2 * j + 1].w);
                        *(GAS v4u*)(xr + 512 * j) = o; }
                    const float rx = 1.f / sqrtf(wave_sum(ssx) * (1.f / DM) + RMS_EPS);
                    if (lane == 0) ((GAS float*)(ws + WS_RX))[m] = rx;
                } else {
                    float* orow = out + (size_t)m * DM + lane * 8;
#pragma unroll
                    for (int j = 0; j < 8; ++j) __builtin_nontemporal_store(v[j], (f32x4*)(orow + 512 * (j >> 1) + 4 * (j & 1)));
                }
            }
        }
        if (PROBE_MASK) __syncthreads();
        }
        if (ph + 1 < args.ph_hi) {
            if (ph == args.ph_lo) { cooperative_groups::this_grid().sync(); xbar = xcd_barrier_post(barw, xst); }
            else xcd_barrier(xbar);
        }
    }
}

extern "C" void kernel_launch(void* const* d_in, const int* in_sizes, int n_in, void* d_out, int out_size, void* d_ws, size_t ws_size, hipStream_t stream) {
    static int grid = 0;
    if (grid == 0) {
        if (n_in != 15 || in_sizes[0] != M * DM || out_size != M * DM || ws_size < WS_END) { fprintf(stderr, "kernel_launch: unexpected shapes (n_in %d, in0 %d, out %d, ws %zu)\n", n_in, n_in > 0 ? in_sizes[0] : -1, out_size, ws_size); grid = -1; return; }
        int dev = 0, cus = 0, per_cu = 0;
        (void)hipGetDevice(&dev); (void)hipDeviceGetAttribute(&cus, hipDeviceAttributeMultiprocessorCount, dev);
        if (hipFuncSetAttribute((const void*)mk_fwd, hipFuncAttributeMaxDynamicSharedMemorySize, LDS_BYTES) != hipSuccess) { fprintf(stderr, "kernel_launch: hipFuncSetAttribute failed\n"); grid = -1; return; }
        if (hipOccupancyMaxActiveBlocksPerMultiprocessor(&per_cu, (const void*)mk_fwd, NWAVES * 64, LDS_BYTES) != hipSuccess || per_cu < 1) { fprintf(stderr, "kernel_launch: occupancy query says %d\n", per_cu); per_cu = 1; }
        (void)hipGetLastError();
        grid = cus > 0 ? cus : 256;
    }
    if (grid < 0) return;
    Args a{};
    for (int i = 0; i < 15; ++i) a.in[i] = (const float*)d_in[i];
    a.out = (float*)d_out; a.ws = (unsigned char*)d_ws;
#if MK_N_LAUNCHES == 1
    a.ph_lo = 0; a.ph_hi = N_PHASES;
    void* kargs[] = {&a};
    hipError_t e = hipLaunchCooperativeKernel((const void*)mk_fwd, dim3(grid), dim3(NWAVES * 64), kargs, LDS_BYTES, stream);
    if (e != hipSuccess) fprintf(stderr, "kernel_launch: cooperative launch failed: %s (grid %d)\n", hipGetErrorString(e), grid);
#else
    for (int p = 0; p < N_PHASES; ++p) { a.ph_lo = p; a.ph_hi = p + 1; hipLaunchKernelGGL(mk_fwd, dim3(grid), dim3(NWAVES * 64), LDS_BYTES, stream, a); }
#endif
}
```
